# Optimizing an MI355X kernel written in HIP

```python
import jax, jax.numpy as jnp
from jax import lax
import numpy as np

D_MODEL = 1024
BATCH = 32
SEQ = 2048
DEPTH = 1
DEC_BATCH = 8
DEC_SEQ = 2048
PAST_LEN = 128

D_RNN = 1280
LRU_BLOCKS = 16
LRU_BW = D_RNN // LRU_BLOCKS
LRU_C = 8.0
LRU_CONV = 4
ATT_GROUPS = ((128, 1), (512, 4), (2048, 16))
N_GROUPS = len(ATT_GROUPS)
HEADS_PER_GROUP = 8
HEAD_DIM = 64
ATT_COLS = N_GROUPS * HEADS_PER_GROUP * HEAD_DIM
ATT_OUT = HEADS_PER_GROUP * HEAD_DIM
ROT_DIM = HEAD_DIM // 4
ROPE_THETA = 500000.0
D_FF = 3 * D_MODEL
FFN_CONV = 3
EPS = 1e-6
NEG = -1e30
IN_COLS = 2 * D_RNN + 3 * ATT_COLS + 2 * D_MODEL

kernel_name = 'hybrid_rglru_dilated_attn_encoder'


def _rmsnorm(x, g):
    xf = x.astype(jnp.float32)
    y = xf * lax.rsqrt(jnp.mean(xf * xf, axis=-1, keepdims=True) + EPS)
    return (y * g.astype(jnp.float32)).astype(x.dtype)


def _dwconv(x, w, b):
    K = w.shape[0]
    S = x.shape[1]
    lo = K // 2
    xp = jnp.pad(x, ((0, 0), (lo, K - 1 - lo), (0, 0)))
    out = b
    for j in range(K):
        out = out + xp[:, j:j + S, :] * w[j]
    return out


def _lin_combine(e1, e2):
    a1, b1 = e1
    a2, b2 = e2
    return a1 * a2, a2 * b1 + b2


def _rglru_direction(xc, wa, ba, wx, bx, lam):
    B, S, _ = xc.shape
    xb = xc.reshape(B, S, LRU_BLOCKS, LRU_BW)
    r = jax.nn.sigmoid((jnp.einsum('bsnc,ncd->bsnd', xb, wa).reshape(B, S, D_RNN) + ba).astype(jnp.float32))
    i = jax.nn.sigmoid((jnp.einsum('bsnc,ncd->bsnd', xb, wx).reshape(B, S, D_RNN) + bx).astype(jnp.float32))
    log_a = -LRU_C * r * jax.nn.softplus(-lam.astype(jnp.float32))
    a = jnp.exp(log_a)
    u = jnp.sqrt(-jnp.expm1(2.0 * log_a)) * (i * xc.astype(jnp.float32))
    _, h = lax.associative_scan(_lin_combine, (a, u), axis=1)
    return h


def _rope(x, cos, sin):
    half = ROT_DIM // 2
    xf = x.astype(jnp.float32)
    x1 = xf[..., :half]
    x2 = xf[..., half:ROT_DIM]
    rot = jnp.concatenate([x1 * cos - x2 * sin, x2 * cos + x1 * sin, xf[..., ROT_DIM:]], axis=-1)
    return rot.astype(x.dtype)


def _banded_attention(q, k, v, half):
    L = q.shape[-2]
    C = half
    n = -(-L // C)
    Lp = n * C
    lead = q.shape[:-2]
    nb = len(lead)
    qb = jnp.pad(q, [(0, 0)] * nb + [(0, Lp - L), (0, 0)]).reshape(lead + (n, C, HEAD_DIM))

    def windows(t):
        tb = jnp.pad(t, [(0, 0)] * nb + [(C, Lp - L + C), (0, 0)]).reshape(lead + (n + 2, C, HEAD_DIM))
        return jnp.concatenate([tb[..., :-2, :, :], tb[..., 1:-1, :, :], tb[..., 2:, :, :]], axis=-2)

    kw = windows(k)
    vw = windows(v)
    qpos = jnp.arange(n)[:, None] * C + jnp.arange(C)[None, :]
    kpos = jnp.arange(n)[:, None] * C - C + jnp.arange(3 * C)[None, :]
    kp = kpos[:, None, :]
    mask = (jnp.abs(qpos[:, :, None] - kp) <= half) & (kp >= 0) & (kp < L)
    s = jnp.einsum('...nqd,...nkd->...nqk', qb, kw, preferred_element_type=jnp.float32) * (HEAD_DIM ** -0.5)
    s = jnp.where(mask, s, NEG)
    lse = jax.nn.logsumexp(s, axis=-1)
    p = jnp.exp(s - lse[..., None])
    o = jnp.einsum('...nqk,...nkd->...nqd', p.astype(v.dtype), vw)
    o = o.reshape(lead + (Lp, HEAD_DIM))[..., :L, :]
    lse = lse.reshape(lead + (Lp,))[..., :L]
    return o, lse


def _dilated_group(q, k, v, window, dilation):
    B, S, H, Dh = q.shape
    L = S // dilation
    half = (window // 2) // dilation

    def split(t):
        return t.reshape(B, L, dilation, H, Dh).transpose(0, 2, 3, 1, 4)

    o, lse = _banded_attention(split(q), split(k), split(v), half)
    o = o.transpose(0, 3, 1, 2, 4).reshape(B, S, H, Dh)
    lse = lse.transpose(0, 3, 1, 2).reshape(B, S, H)
    return o, lse


def _layer(x, norm1_g, w_in, lru_conv_w, lru_conv_b, lru_wa, lru_ba, lru_wx, lru_bx, lru_lambda,
           w_lru_out, q_norm_g, k_norm_g, w_att_out, w_o, norm2_g, w_up, ffn_conv_w, ffn_conv_b, w_down):
    B, S, _ = x.shape
    xn = _rmsnorm(x, norm1_g)
    proj = xn @ w_in
    c0 = D_RNN
    c1 = 2 * D_RNN
    c2 = c1 + ATT_COLS
    c3 = c2 + ATT_COLS
    c4 = c3 + ATT_COLS
    lru_x, lru_gate, q, k, v, gates = jnp.split(proj, [c0, c1, c2, c3, c4], axis=-1)

    xc = _dwconv(lru_x, lru_conv_w, lru_conv_b)
    h_fwd = _rglru_direction(xc, lru_wa[0], lru_ba[0], lru_wx[0], lru_bx[0], lru_lambda[0])
    h_bwd = jnp.flip(_rglru_direction(jnp.flip(xc, axis=1), lru_wa[1], lru_ba[1], lru_wx[1], lru_bx[1], lru_lambda[1]), axis=1)
    a_out = (jax.nn.gelu(lru_gate) * (h_fwd + h_bwd).astype(x.dtype)) @ w_lru_out

    shp = (B, S, N_GROUPS, HEADS_PER_GROUP, HEAD_DIM)
    pos = jnp.arange(S, dtype=jnp.float32)
    inv = ROPE_THETA ** (-jnp.arange(0, ROT_DIM, 2, dtype=jnp.float32) / ROT_DIM)
    ang = pos[:, None] * inv[None, :]
    cos = jnp.cos(ang)[:, None, None, :]
    sin = jnp.sin(ang)[:, None, None, :]
    q = _rope(_rmsnorm(q.reshape(shp), q_norm_g[:, None, :]), cos, sin)
    k = _rope(_rmsnorm(k.reshape(shp), k_norm_g[:, None, :]), cos, sin)
    v = v.reshape(shp)
    outs = []
    lses = []
    for g, (window, dilation) in enumerate(ATT_GROUPS):
        o_g, lse_g = _dilated_group(q[:, :, g], k[:, :, g], v[:, :, g], window, dilation)
        outs.append(o_g)
        lses.append(lse_g)
    wts = jax.nn.softmax(jnp.stack(lses, axis=0), axis=0)
    o = jnp.sum(wts[..., None] * jnp.stack(outs, axis=0).astype(jnp.float32), axis=0).astype(x.dtype)
    b_out = o.reshape(B, S, ATT_OUT) @ w_att_out

    g = jax.nn.sigmoid(gates)
    g_a, g_b = jnp.split(g, 2, axis=-1)
    x = x + (g_a * a_out + g_b * b_out) @ w_o

    xn2 = _rmsnorm(x, norm2_g)
    up = xn2 @ w_up
    gate, val = jnp.split(up, 2, axis=-1)
    gate = _dwconv(gate, ffn_conv_w, ffn_conv_b)
    x = x + (jax.nn.gelu(gate) * val) @ w_down
    return x


def _trunk(x, params):
    for l in range(DEPTH):
        x = _layer(x, **{name: p[l] for name, p in params.items()})
    return x


def setup_inputs(seed: int = 0) -> dict:
    key = jax.random.key(seed)
    ks = jax.random.split(key, 24)
    f32 = jnp.float32
    nrm = lambda k, s, sc: jax.random.normal(k, s, f32) * sc
    u = jax.random.uniform(ks[9], (DEPTH, 2, D_RNN), f32, minval=0.9, maxval=0.999)
    a0 = u ** (1.0 / LRU_C)
    lam = jnp.log(a0) - jnp.log1p(-a0)
    return {
        'x_prompt': nrm(ks[0], (BATCH, SEQ, D_MODEL), 1.0),
        'x_sample': nrm(ks[1], (DEC_BATCH, DEC_SEQ, D_MODEL), 1.0),
        'norm1_g': 1.0 + nrm(ks[2], (DEPTH, D_MODEL), 0.02),
        'w_in': nrm(ks[3], (DEPTH, D_MODEL, IN_COLS), D_MODEL ** -0.5),
        'lru_conv_w': nrm(ks[4], (DEPTH, LRU_CONV, D_RNN), LRU_CONV ** -0.5),
        'lru_conv_b': nrm(ks[5], (DEPTH, D_RNN), 0.02),
        'lru_wa': nrm(ks[6], (DEPTH, 2, LRU_BLOCKS, LRU_BW, LRU_BW), LRU_BW ** -0.5),
        'lru_ba': nrm(ks[7], (DEPTH, 2, D_RNN), 0.02),
        'lru_wx': nrm(ks[8], (DEPTH, 2, LRU_BLOCKS, LRU_BW, LRU_BW), LRU_BW ** -0.5),
        'lru_bx': nrm(ks[10], (DEPTH, 2, D_RNN), 0.02),
        'lru_lambda': lam,
        'w_lru_out': nrm(ks[11], (DEPTH, D_RNN, D_MODEL), D_RNN ** -0.5),
        'q_norm_g': 1.0 + nrm(ks[12], (DEPTH, N_GROUPS, HEAD_DIM), 0.02),
        'k_norm_g': 1.0 + nrm(ks[13], (DEPTH, N_GROUPS, HEAD_DIM), 0.02),
        'w_att_out': nrm(ks[14], (DEPTH, ATT_OUT, D_MODEL), ATT_OUT ** -0.5),
        'w_o': nrm(ks[15], (DEPTH, D_MODEL, D_MODEL), D_MODEL ** -0.5),
        'norm2_g': 1.0 + nrm(ks[16], (DEPTH, D_MODEL), 0.02),
        'w_up': nrm(ks[17], (DEPTH, D_MODEL, 2 * D_FF), D_MODEL ** -0.5),
        'ffn_conv_w': nrm(ks[18], (DEPTH, FFN_CONV, D_FF), FFN_CONV ** -0.5),
        'ffn_conv_b': nrm(ks[19], (DEPTH, D_FF), 0.02),
        'w_down': nrm(ks[20], (DEPTH, D_FF, D_MODEL), D_FF ** -0.5),
    }


def reference(x_prompt, x_sample, norm1_g, w_in, lru_conv_w, lru_conv_b, lru_wa, lru_ba, lru_wx, lru_bx,
              lru_lambda, w_lru_out, q_norm_g, k_norm_g, w_att_out, w_o, norm2_g, w_up, ffn_conv_w,
              ffn_conv_b, w_down):
    params = dict(norm1_g=norm1_g, w_in=w_in, lru_conv_w=lru_conv_w, lru_conv_b=lru_conv_b,
                  lru_wa=lru_wa, lru_ba=lru_ba, lru_wx=lru_wx, lru_bx=lru_bx, lru_lambda=lru_lambda,
                  w_lru_out=w_lru_out, q_norm_g=q_norm_g, k_norm_g=k_norm_g, w_att_out=w_att_out,
                  w_o=w_o, norm2_g=norm2_g, w_up=w_up, ffn_conv_w=ffn_conv_w, ffn_conv_b=ffn_conv_b,
                  w_down=w_down)
    y_prompt = _trunk(x_prompt, params)
    y_sample = _trunk(x_sample, params)
    return (y_prompt, y_sample)
```

```cpp
#include <hip/hip_runtime.h>
#include <hip/hip_cooperative_groups.h>
#include <cstdio>
#include <cstdint>
namespace cg = cooperative_groups;
namespace pg8 {
#define PG8_LAS __attribute__((address_space(3)))
typedef unsigned short bf16_t;
typedef short bf16x8 __attribute__((ext_vector_type(8)));
typedef float f32x4 __attribute__((ext_vector_type(4)));
typedef unsigned u32x4 __attribute__((ext_vector_type(4)));
constexpr int BM = 256, BK = 64, HALF = 128, HTB = HALF * BK * 2  , STAGE_BYTES = 8 * HTB, NXCD = 8, WGM = 8;

__host__ __device__ __forceinline__ int lds_byte(int r, int c) { const int st = (r >> 4) * 2 + (c >> 5), rr = r & 15, cc = c & 31, ob = rr * 64 + cc * 2; return st * 1024 + (ob ^ (((ob >> 9) & 1) << 5)); }
__host__ __device__ __forceinline__ void stage_rc(int b, int& R, int& C) { const int st = b / 1024, sb = b % 1024, swz = sb ^ (((sb >> 9) & 1) << 5); R = (st >> 1) * 16 + swz / 64; C = (st & 1) * 32 + (swz % 64) / 2; }
__host__ __device__ __forceinline__ int perm32(int rho) { const int n = rho >> 4, i = rho & 15; return 8 * (i >> 2) + 4 * n + (i & 3); }

struct Unit { int pm, pn; };
struct Gemm { const bf16_t* A; const bf16_t* Bt; int M, N, K; };

struct StaticOrder {
    int nM, nN, nwg, G, c;
    __host__ __device__ void init(int M, int N, int G_, int c_) { nM = M / BM; nN = N / BM; nwg = nM * nN; G = G_; c = c_; }
    __host__ __device__ bool next(int i, Unit& u) const {
        const long L = (long)i * G + c; if (L >= nwg) return false;
        int wgid = (int)L; { const int q = nwg / NXCD, r = nwg % NXCD, xcd = wgid % NXCD, off = wgid / NXCD; wgid = (xcd < r ? xcd * (q + 1) : r * (q + 1) + (xcd - r) * q) + off; }
        const int nig = WGM * nN, gid = wgid / nig, fm = gid * WGM, gsz = (nM - fm) < WGM ? (nM - fm) : WGM;
        u.pm = fm + ((wgid % nig) % gsz); u.pn = (wgid % nig) / gsz; return true;
    }
    __device__ __forceinline__ void a_ready(const Unit&) const {}
    __device__ __forceinline__ void done(const Unit&) const {}
};

__device__ __forceinline__ unsigned cvt_pk_bf16(float lo, float hi) { unsigned r; asm volatile("v_cvt_pk_bf16_f32 %0, %1, %2" : "=v"(r) : "v"(lo), "v"(hi)); return r; }
typedef float f32x2 __attribute__((ext_vector_type(2)));
typedef unsigned u32x2 __attribute__((ext_vector_type(2)));
__device__ __forceinline__ float fast_rcp(float x) { return __builtin_amdgcn_rcpf(x); }
__device__ __forceinline__ float sigmoid_f(float x) { return fast_rcp(1.0f + __expf(-x)); }
__device__ __forceinline__ float gelu_tanh_f(float x) { const float u = 0.7978845608028654f * (x + 0.044715f * x * x * x); return x * fast_rcp(1.0f + __expf(-2.0f * u)); }
__device__ __forceinline__ float bf_lo(unsigned w) { return __uint_as_float(w << 16); }
__device__ __forceinline__ float bf_hi(unsigned w) { return __uint_as_float(w & 0xffff0000u); }

struct EpiProj {
    static constexpr bool PERM = true, AFTER_DRAIN = false;
    bf16_t *XL, *GL, *QB, *KB, *VB, *GT; const float* RT; const float* qg; const float* kg; float qscale;
    __device__ __forceinline__ static int permpos(int t, int g) { const int dsh = 2 * g; return (t & ((1 << dsh) - 1)) * (2048 >> dsh) + (t >> dsh); }
    __device__ __forceinline__ void operator()(const f32x4 (&acc)[2][2][4][2], const Unit& u, int wr, int wc, int fr, int fq) const {
        const int colt = u.pn * BM;
        const int row0 = u.pm * BM + wr * 64 + fr;
        if (colt >= 2560 && colt < 5632) {
            const bool isk = colt >= 4096; const int cb0 = colt - (isk ? 4096 : 2560); const int grp = cb0 >> 9; const int gh = (cb0 >> 6) + wc;
            const float* gp = (isk ? kg : qg) + grp * 64 + 8 * fq;
            f32x4 gn[2][2];
#pragma unroll
            for (int bj = 0; bj < 2; ++bj)
#pragma unroll
                for (int n = 0; n < 2; ++n) gn[bj][n] = *(const f32x4*)(gp + 32 * bj + 4 * n);
            const float sc = isk ? 1.0f : qscale;
            bf16_t* OB = isk ? KB : QB;
#pragma unroll
            for (int ai = 0; ai < 2; ++ai)
#pragma unroll
                for (int m = 0; m < 4; ++m) { const int lrow = row0 + ai * HALF + m * 16; const int pos = lrow & 2047, bb = lrow >> 11;
                    f32x4 y[2][2]; float ss = 0.f;
#pragma unroll
                    for (int bj = 0; bj < 2; ++bj)
#pragma unroll
                        for (int n = 0; n < 2; ++n) { y[bj][n] = acc[ai][bj][m][n]; ss += (y[bj][n][0] * y[bj][n][0] + y[bj][n][1] * y[bj][n][1]) + (y[bj][n][2] * y[bj][n][2] + y[bj][n][3] * y[bj][n][3]); }
                    ss += __shfl_xor(ss, 16); ss += __shfl_xor(ss, 32);
                    const float rs = __builtin_amdgcn_rsqf(ss * (1.0f / 64.0f) + 1e-6f);
#pragma unroll
                    for (int bj = 0; bj < 2; ++bj)
#pragma unroll
                        for (int n = 0; n < 2; ++n) y[bj][n] = y[bj][n] * gn[bj][n] * rs;
#pragma unroll
                    for (int n = 0; n < 2; ++n) { f32x4 pr;
#pragma unroll
                        for (int e = 0; e < 4; ++e) pr[e] = __shfl_xor(y[0][n][e], 16);
                        if (fq < 2) { const f32x4 t0 = *(const f32x4*)(RT + (size_t)pos * 16 + 8 * n), t1 = *(const f32x4*)(RT + (size_t)pos * 16 + 8 * n + 4);
                            const float co[4] = {t0[0], t0[2], t1[0], t1[2]}, si[4] = {t0[1], t0[3], t1[1], t1[3]};
#pragma unroll
                            for (int e = 0; e < 4; ++e) y[0][n][e] = (fq == 0) ? (y[0][n][e] * co[e] - pr[e] * si[e]) : (y[0][n][e] * co[e] + pr[e] * si[e]); } }
                    bf16_t* rowp = OB + ((size_t)(bb * 24 + gh) * 2048 + permpos(pos, grp)) * 64 + 8 * fq;
#pragma unroll
                    for (int bj = 0; bj < 2; ++bj) { const f32x4 v0 = y[bj][0] * sc, v1 = y[bj][1] * sc;
                        u32x4 w; w.x = cvt_pk_bf16(v0[0], v0[1]); w.y = cvt_pk_bf16(v0[2], v0[3]); w.z = cvt_pk_bf16(v1[0], v1[1]); w.w = cvt_pk_bf16(v1[2], v1[3]);
                        *(u32x4*)(rowp + 32 * bj) = w; }
                    asm volatile("" ::: "memory"); }
            return;
        }
        const int mode = (colt >= 7168) ? 2 : ((colt >= 1280 && colt < 2560) ? 1 : 0);
        const int col0 = colt + wc * 32 + 8 * fq;
#pragma unroll
        for (int ai = 0; ai < 2; ++ai)
#pragma unroll
            for (int m = 0; m < 4; ++m) { const int lrow = row0 + ai * HALF + m * 16; const int pos = lrow & 2047, bb = lrow >> 11;
#pragma unroll
                for (int bj = 0; bj < 2; ++bj) { f32x4 v0 = acc[ai][bj][m][0], v1 = acc[ai][bj][m][1];
                    const int col = col0 + bj * HALF; bf16_t* dst;
                    if (colt < 2560) { const int cc = col - (mode == 1 ? 1280 : 0); const int nb = cc / 80, c = cc - nb * 80; dst = (mode == 1 ? GL : XL) + ((size_t)(bb * 16 + nb) * 2048 + pos) * 80 + c; }
                    else if (colt < 7168) { const int cv = col - 5632; const int gh = cv >> 6; dst = VB + ((size_t)(bb * 24 + gh) * 2048 + permpos(pos, gh >> 3)) * 64 + (cv & 63); }
                    else dst = GT + (size_t)lrow * 2048 + (col - 7168);
                    if (mode == 1) {
#pragma unroll
                        for (int e = 0; e < 4; ++e) { v0[e] = gelu_tanh_f(v0[e]); v1[e] = gelu_tanh_f(v1[e]); } }
                    else if (mode == 2) {
                        unsigned q[8];
#pragma unroll
                        for (int e = 0; e < 4; ++e) { q[e] = (unsigned)(sigmoid_f(v0[e]) * 255.0f + 0.5f); q[4 + e] = (unsigned)(sigmoid_f(v1[e]) * 255.0f + 0.5f); }
                        u32x2 wq; wq.x = q[0] | (q[1] << 8) | (q[2] << 16) | (q[3] << 24); wq.y = q[4] | (q[5] << 8) | (q[6] << 16) | (q[7] << 24);
                        *(u32x2*)((unsigned char*)GT + (size_t)lrow * 2048 + (col - 7168)) = wq;
                        continue; }
                    u32x4 w; w.x = cvt_pk_bf16(v0[0], v0[1]); w.y = cvt_pk_bf16(v0[2], v0[3]); w.z = cvt_pk_bf16(v1[0], v1[1]); w.w = cvt_pk_bf16(v1[2], v1[3]);
                    *(u32x4*)dst = w; } }
    }
};
template <bool SECOND> struct EpiMerge {
    static constexpr bool PERM = true, AFTER_DRAIN = false;
    bf16_t* MG; const unsigned char* G; int ldg;
    __device__ __forceinline__ void operator()(const f32x4 (&acc)[2][2][4][2], const Unit& u, int wr, int wc, int fr, int fq) const {
        const int row0 = u.pm * BM + wr * 64 + fr, col0 = u.pn * BM + wc * 32 + 8 * fq;
#pragma unroll
        for (int ai = 0; ai < 2; ++ai)
#pragma unroll
            for (int m = 0; m < 4; ++m) { const size_t row = (size_t)(row0 + ai * HALF + m * 16);
#pragma unroll
                for (int bj = 0; bj < 2; ++bj) { const f32x4 v0 = acc[ai][bj][m][0], v1 = acc[ai][bj][m][1];
                    const u32x2 g = *(const u32x2*)(G + row * ldg + col0 + bj * HALF);
                    float o[8]; const float k255 = 1.0f / 255.0f;
                    o[0] = v0[0] * ((float)(g.x & 0xffu) * k255); o[1] = v0[1] * ((float)((g.x >> 8) & 0xffu) * k255); o[2] = v0[2] * ((float)((g.x >> 16) & 0xffu) * k255); o[3] = v0[3] * ((float)(g.x >> 24) * k255);
                    o[4] = v1[0] * ((float)(g.y & 0xffu) * k255); o[5] = v1[1] * ((float)((g.y >> 8) & 0xffu) * k255); o[6] = v1[2] * ((float)((g.y >> 16) & 0xffu) * k255); o[7] = v1[3] * ((float)(g.y >> 24) * k255);
                    bf16_t* dst = MG + row * 1024 + col0 + bj * HALF;
                    if (SECOND) { const u32x4 p = *(const u32x4*)dst;
                        o[0] += bf_lo(p.x); o[1] += bf_hi(p.x); o[2] += bf_lo(p.y); o[3] += bf_hi(p.y); o[4] += bf_lo(p.z); o[5] += bf_hi(p.z); o[6] += bf_lo(p.w); o[7] += bf_hi(p.w); }
                    u32x4 w; w.x = cvt_pk_bf16(o[0], o[1]); w.y = cvt_pk_bf16(o[2], o[3]); w.z = cvt_pk_bf16(o[4], o[5]); w.w = cvt_pk_bf16(o[6], o[7]);
                    *(u32x4*)dst = w; } }
    }
};
struct EpiWo {
    static constexpr bool PERM = false, AFTER_DRAIN = false;
    const float* xp; const float* xs; float* OUT; bf16_t* XB; float* SS; int grow0;
    __device__ __forceinline__ void operator()(const f32x4 (&acc)[2][2][4][2], const Unit& u, int wr, int wc, int fr, int fq) const {
        const int row0 = u.pm * BM + wr * 64 + fr, col0 = u.pn * BM + wc * 32 + 4 * fq;
#pragma unroll
        for (int ai = 0; ai < 2; ++ai)
#pragma unroll
            for (int m = 0; m < 4; ++m) { const int lrow = row0 + ai * HALF + m * 16; const int grow = grow0 + lrow;
                const float* xr = (grow < 65536) ? xp + (size_t)grow * 1024 : xs + (size_t)(grow - 65536) * 1024;
                bf16_t* brow = XB + (size_t)lrow * 1024; float ss = 0.f;
#pragma unroll
                for (int bj = 0; bj < 2; ++bj)
#pragma unroll
                    for (int n = 0; n < 2; ++n) { const int c = col0 + bj * HALF + n * 16; const f32x4 xv = *(const f32x4*)(xr + c); const f32x4 o = xv + acc[ai][bj][m][n];
                        ss += (o[0] * o[0] + o[1] * o[1]) + (o[2] * o[2] + o[3] * o[3]);
                        u32x2 w; w.x = cvt_pk_bf16(o[0], o[1]); w.y = cvt_pk_bf16(o[2], o[3]); *(u32x2*)(brow + c) = w; }
                ss += __shfl_xor(ss, 16); ss += __shfl_xor(ss, 32);
                if (fq == 0) atomicAdd(SS + grow, ss); }
    }
};
struct EpiUp {
    static constexpr bool PERM = true, AFTER_DRAIN = false;
    bf16_t* O; const float* SS; int grow0;
    __device__ __forceinline__ void operator()(const f32x4 (&acc)[2][2][4][2], const Unit& u, int wr, int wc, int fr, int fq) const {
        const int row0 = u.pm * BM + wr * 64 + fr, col0 = u.pn * BM + wc * 32 + 8 * fq;
#pragma unroll
        for (int ai = 0; ai < 2; ++ai)
#pragma unroll
            for (int m = 0; m < 4; ++m) { const int lrow = row0 + ai * HALF + m * 16; const float rs = __builtin_amdgcn_rsqf(SS[grow0 + lrow] * (1.0f / 1024.0f) + 1e-6f);
                bf16_t* rowp = O + (size_t)lrow * 6144 + col0;
#pragma unroll
                for (int bj = 0; bj < 2; ++bj) { const f32x4 v0 = acc[ai][bj][m][0] * rs, v1 = acc[ai][bj][m][1] * rs;
                    u32x4 w; w.x = cvt_pk_bf16(v0[0], v0[1]); w.y = cvt_pk_bf16(v0[2], v0[3]); w.z = cvt_pk_bf16(v1[0], v1[1]); w.w = cvt_pk_bf16(v1[2], v1[3]);
                    *(u32x4*)(rowp + bj * HALF) = w; }
                asm volatile("" ::: "memory"); }
    }
};
struct EpiUpFused {
    static constexpr bool PERM = true, AFTER_DRAIN = false;
    bf16_t* H; const float* SS; int grow0; const float* cw; const float* cb; float* SB;
    __device__ __forceinline__ void operator()(const f32x4 (&acc)[2][2][4][2], const Unit& u, int wr, int wc, int fr, int fq) const {
        const int lane = fq * 16 + fr, srcP = (lane & 48) | ((fr + 15) & 15), srcN = (lane & 48) | ((fr + 1) & 15);
        const int row0 = u.pm * BM + wr * 64 + fr, ch0 = u.pn * HALF + wc * 32 + 8 * fq;
#pragma unroll
        for (int ai = 0; ai < 2; ++ai) {
            float rs[4];
#pragma unroll
            for (int m = 0; m < 4; ++m) rs[m] = __builtin_amdgcn_rsqf(SS[grow0 + row0 + ai * HALF + m * 16] * (1.0f / 1024.0f) + 1e-6f);
            const int er = ((u.pm * 4 + 2 * ai + wr) * 2) * 9216;
#pragma unroll
            for (int n = 0; n < 2; ++n) {
                const int ch = ch0 + 4 * n;
                const f32x4 w0 = *(const f32x4*)(cw + ch), w1 = *(const f32x4*)(cw + 3072 + ch), w2 = *(const f32x4*)(cw + 6144 + ch), bb = *(const f32x4*)(cb + ch);
                float o[4][4], pp[4][4], gg[4][4];
#pragma unroll
                for (int e = 0; e < 4; ++e) {
                    float g[4], R[4], L[4];
#pragma unroll
                    for (int m = 0; m < 4; ++m) { g[m] = acc[ai][0][m][n][e] * rs[m]; R[m] = __shfl(g[m], srcP); L[m] = __shfl(g[m], srcN); }
#pragma unroll
                    for (int m = 0; m < 4; ++m) {
                        const float gp = (fr == 0) ? (m > 0 ? R[m > 0 ? m - 1 : 0] : 0.f) : R[m];
                        const float gn = (fr == 15) ? (m < 3 ? L[m < 3 ? m + 1 : 3] : 0.f) : L[m];
                        const float pre = bb[e] + w0[e] * gp + w1[e] * g[m] + w2[e] * gn;
                        pp[m][e] = pre; gg[m][e] = g[m];
                        o[m][e] = gelu_tanh_f(pre) * (acc[ai][1][m][n][e] * rs[m]);
                    }
                }
#pragma unroll
                for (int m = 0; m < 4; ++m) {
                    const bool edge = (m == 0 && fr == 0) || (m == 3 && fr == 15);
                    if (!edge) { u32x2 w; w.x = cvt_pk_bf16(o[m][0], o[m][1]); w.y = cvt_pk_bf16(o[m][2], o[m][3]); *(u32x2*)(H + (size_t)(row0 + ai * HALF + m * 16) * 3072 + ch) = w; }
                }
                if (fr == 0) { float* sb = SB + er + ch;
                    *(f32x4*)(sb) = (f32x4){gg[0][0], gg[0][1], gg[0][2], gg[0][3]}; *(f32x4*)(sb + 3072) = (f32x4){pp[0][0], pp[0][1], pp[0][2], pp[0][3]};
                    *(f32x4*)(sb + 6144) = (f32x4){acc[ai][1][0][n][0] * rs[0], acc[ai][1][0][n][1] * rs[0], acc[ai][1][0][n][2] * rs[0], acc[ai][1][0][n][3] * rs[0]}; }
                if (fr == 15) { float* sb = SB + er + 9216 + ch;
                    *(f32x4*)(sb) = (f32x4){gg[3][0], gg[3][1], gg[3][2], gg[3][3]}; *(f32x4*)(sb + 3072) = (f32x4){pp[3][0], pp[3][1], pp[3][2], pp[3][3]};
                    *(f32x4*)(sb + 6144) = (f32x4){acc[ai][1][3][n][0] * rs[3], acc[ai][1][3][n][1] * rs[3], acc[ai][1][3][n][2] * rs[3], acc[ai][1][3][n][3] * rs[3]}; }
            }
            asm volatile("" ::: "memory");
        }
    }
};
struct EpiDown {
    static constexpr bool PERM = false, AFTER_DRAIN = false;
    float* OUT; const bf16_t* XB; int grow0;
    __device__ __forceinline__ void operator()(const f32x4 (&acc)[2][2][4][2], const Unit& u, int wr, int wc, int fr, int fq) const {
        const int row0 = u.pm * BM + wr * 64 + fr, col0 = u.pn * BM + wc * 32 + 4 * fq;
#pragma unroll
        for (int ai = 0; ai < 2; ++ai)
#pragma unroll
            for (int m = 0; m < 4; ++m) { const int lrow = row0 + ai * HALF + m * 16; float* orow = OUT + (size_t)(grow0 + lrow) * 1024; const bf16_t* brow = XB + (size_t)lrow * 1024;
#pragma unroll
                for (int bj = 0; bj < 2; ++bj)
#pragma unroll
                    for (int n = 0; n < 2; ++n) { const int c = col0 + bj * HALF + n * 16; const u32x2 xw = *(const u32x2*)(brow + c);
                        const f32x4 xv = (f32x4){bf_lo(xw.x), bf_hi(xw.x), bf_lo(xw.y), bf_hi(xw.y)}; *(f32x4*)(orow + c) = xv + acc[ai][bj][m][n]; } }
    }
};
template <class Epi, class Sched, bool ALIGN_EPI = false, bool SP2 = false>
__device__ __forceinline__ void gemm_phase(PG8_LAS unsigned char* lds, const Gemm g, const Sched& S, const Epi& E) {
    int tid_ = threadIdx.x; asm volatile("" : "+v"(tid_));
    const int tid = tid_, wid = __builtin_amdgcn_readfirstlane(tid >> 6), lane = tid & 63, wr = wid >> 2, wc = wid & 3, fr = lane & 15, fq = lane >> 4;
    const int K = g.K, nt = K / BK;
    unsigned voffA[2], voffB[2];
#pragma unroll
    for (int i = 0; i < 2; ++i) { int R, C; stage_rc(tid * 16 + i * 8192, R, C); const int Rb = Epi::PERM ? ((R & ~31) + perm32(R & 31)) : R;
        voffA[i] = (unsigned)(R * K + C) * 2u; voffB[i] = (unsigned)(Rb * K + C) * 2u; }
    const size_t kstep = (size_t)(BK * 2);
    const size_t hstep = (size_t)HALF * K * 2;
    const size_t tstep = 2 * hstep;
    const unsigned ldsw = (unsigned)wid * 1024u;
    const int aoff = lds_byte(wr * 64 + fr, fq * 8), boff = lds_byte(wc * 32 + fr, fq * 8);
#define PG8_SA(b, h) (((b) * 2 + (h)) * HTB)
#define PG8_SB(b, h) ((4 + (b) * 2 + (h)) * HTB)
#define PG8_STAGE(bufoff, gbase, voff) do { _Pragma("unroll") for (int _i = 0; _i < 2; ++_i) \
        __builtin_amdgcn_global_load_lds((const unsigned*)((const char*)(gbase) + (voff)[_i]), (PG8_LAS unsigned*)(lds + (bufoff) + ldsw + _i * 8192), 16, 0, 0); } while (0)
#define PG8_LDA(dst, b, h) do { _Pragma("unroll") for (int m = 0; m < 4; ++m) _Pragma("unroll") for (int k = 0; k < 2; ++k) dst[m][k] = *(const PG8_LAS bf16x8*)(lds + PG8_SA(b, h) + aoff + m * 2048 + k * 1024); } while (0)
#define PG8_LDB(dst, b, h) do { _Pragma("unroll") for (int n = 0; n < 2; ++n) _Pragma("unroll") for (int k = 0; k < 2; ++k) dst[n][k] = *(const PG8_LAS bf16x8*)(lds + PG8_SB(b, h) + boff + n * 2048 + k * 1024); } while (0)
#define PG8_MMA(ai, bj, At, Bt) do { __builtin_amdgcn_s_setprio(1); _Pragma("unroll") for (int m = 0; m < 4; ++m) _Pragma("unroll") for (int n = 0; n < 2; ++n) _Pragma("unroll") for (int k = 0; k < 2; ++k) \
        acc[ai][bj][m][n] = __builtin_amdgcn_mfma_f32_16x16x32_bf16(Bt[n][k], At[m][k], acc[ai][bj][m][n], 0, 0, 0); __builtin_amdgcn_s_setprio(0); } while (0)
#define PG8_WAIT_V(n) asm volatile("s_waitcnt vmcnt(" #n ")" ::: "memory")
#define PG8_WAIT_L(n) asm volatile("s_waitcnt lgkmcnt(" #n ")" ::: "memory")
#define PG8_BAR __builtin_amdgcn_s_barrier()
#define PG8_SCHED __builtin_amdgcn_sched_barrier(0)
    Unit cur, nxt; int ui = 0;
    if (!S.next(0, cur)) return;
    f32x4 acc[2][2][4][2];
#pragma unroll
    for (int a = 0; a < 2; ++a)
#pragma unroll
        for (int b = 0; b < 2; ++b)
#pragma unroll
            for (int m = 0; m < 4; ++m)
#pragma unroll
                for (int n = 0; n < 2; ++n) acc[a][b][m][n] = (f32x4){0.f, 0.f, 0.f, 0.f};
    bf16x8 At[4][2], B0[2][2], B1[2][2];
    const char* cA = (const char*)g.A + (size_t)cur.pm * tstep; const char* cB = (const char*)g.Bt + (size_t)cur.pn * tstep;
    S.a_ready(cur);
    if constexpr (SP2) {
        PG8_STAGE(PG8_SB(0, 0), cB, voffB); PG8_STAGE(PG8_SB(0, 1), cB + hstep, voffB); PG8_STAGE(PG8_SA(0, 0), cA, voffA); PG8_STAGE(PG8_SA(0, 1), cA + hstep, voffA);
        if (wr == 1) PG8_BAR;
        PG8_WAIT_V(2); PG8_BAR;
        PG8_STAGE(PG8_SB(1, 0), cB + kstep, voffB); PG8_STAGE(PG8_SA(1, 0), cA + kstep, voffA); PG8_STAGE(PG8_SB(1, 1), cB + hstep + kstep, voffB);
        PG8_WAIT_V(6); PG8_BAR;
    } else {
        PG8_STAGE(PG8_SB(0, 0), cB, voffB); PG8_STAGE(PG8_SA(0, 0), cA, voffA); PG8_STAGE(PG8_SB(0, 1), cB + hstep, voffB); PG8_STAGE(PG8_SA(0, 1), cA + hstep, voffA);
        if (wr == 1) PG8_BAR;
        PG8_WAIT_V(4); PG8_BAR;
        PG8_STAGE(PG8_SB(1, 0), cB + kstep, voffB); PG8_STAGE(PG8_SA(1, 0), cA + kstep, voffA); PG8_STAGE(PG8_SB(1, 1), cB + hstep + kstep, voffB);
        PG8_WAIT_V(6); PG8_BAR;
    }
    for (;;) {
        const bool has_next = S.next(ui + 1, nxt);
        const char* nA = has_next ? (const char*)g.A + (size_t)nxt.pm * tstep : cA; const char* nB = has_next ? (const char*)g.Bt + (size_t)nxt.pn * tstep : cB;
        for (int t = 0; t < nt; t += 2) {
            const bool last = (t == nt - 2);
            const char* a1 = cA + (size_t)(t + 1) * kstep;
            const char* a2 = last ? nA : cA + (size_t)(t + 2) * kstep; const char* b2 = last ? nB : cB + (size_t)(t + 2) * kstep;
            const char* a3 = a2 + kstep; const char* b3 = b2 + kstep;
            if (last && has_next) S.a_ready(nxt);
            if constexpr (SP2) {
            PG8_LDB(B0, 0, 0); PG8_LDB(B1, 0, 1); PG8_SCHED; PG8_LDA(At, 0, 0); PG8_STAGE(PG8_SA(1, 1), a1 + hstep, voffA);
            PG8_WAIT_V(8); PG8_WAIT_L(0); PG8_BAR; PG8_MMA(0, 0, At, B0); PG8_MMA(0, 1, At, B1); PG8_BAR; PG8_SCHED;
            PG8_LDA(At, 0, 1); PG8_STAGE(PG8_SB(0, 0), b2, voffB); PG8_STAGE(PG8_SB(0, 1), b2 + hstep, voffB); PG8_STAGE(PG8_SA(0, 0), a2, voffA);
            PG8_WAIT_V(8); PG8_WAIT_L(0); PG8_BAR; PG8_MMA(1, 0, At, B0); PG8_MMA(1, 1, At, B1); PG8_BAR; PG8_SCHED;
            PG8_LDB(B0, 1, 0); PG8_LDB(B1, 1, 1); PG8_SCHED; PG8_LDA(At, 1, 0); PG8_STAGE(PG8_SA(0, 1), a2 + hstep, voffA);
            PG8_WAIT_V(8); PG8_WAIT_L(0); PG8_BAR; PG8_MMA(0, 0, At, B0); PG8_MMA(0, 1, At, B1); PG8_BAR; PG8_SCHED;
            PG8_LDA(At, 1, 1); PG8_STAGE(PG8_SB(1, 0), b3, voffB); PG8_STAGE(PG8_SB(1, 1), b3 + hstep, voffB); PG8_STAGE(PG8_SA(1, 0), a3, voffA);
            PG8_WAIT_V(8); PG8_WAIT_L(0); PG8_BAR; PG8_MMA(1, 0, At, B0); PG8_MMA(1, 1, At, B1); PG8_BAR; PG8_SCHED;
            } else {
            PG8_LDB(B0, 0, 0); PG8_SCHED; PG8_LDA(At, 0, 0); PG8_STAGE(PG8_SA(1, 1), a1 + hstep, voffA);
            PG8_WAIT_L(8); PG8_BAR; PG8_WAIT_L(0); PG8_MMA(0, 0, At, B0); PG8_BAR; PG8_SCHED;
            PG8_LDB(B1, 0, 1); PG8_STAGE(PG8_SB(0, 0), b2, voffB);
            PG8_BAR; PG8_WAIT_L(0); PG8_MMA(0, 1, At, B1); PG8_BAR;
            PG8_LDA(At, 0, 1); PG8_STAGE(PG8_SA(0, 0), a2, voffA);
            PG8_BAR; PG8_WAIT_L(0); PG8_MMA(1, 0, At, B0); PG8_BAR; PG8_SCHED;
            PG8_STAGE(PG8_SB(0, 1), b2 + hstep, voffB);
            PG8_WAIT_V(6); PG8_BAR; PG8_MMA(1, 1, At, B1); PG8_BAR;
            PG8_LDB(B0, 1, 0); PG8_SCHED; PG8_LDA(At, 1, 0); PG8_STAGE(PG8_SA(0, 1), a2 + hstep, voffA);
            PG8_WAIT_L(8); PG8_BAR; PG8_WAIT_L(0); PG8_MMA(0, 0, At, B0); PG8_BAR; PG8_SCHED;
            PG8_LDB(B1, 1, 1); PG8_STAGE(PG8_SB(1, 0), b3, voffB);
            PG8_BAR; PG8_WAIT_L(0); PG8_MMA(0, 1, At, B1); PG8_BAR;
            PG8_LDA(At, 1, 1); PG8_STAGE(PG8_SA(1, 0), a3, voffA);
            PG8_BAR; PG8_WAIT_L(0); PG8_MMA(1, 0, At, B0); PG8_BAR; PG8_SCHED;
            PG8_STAGE(PG8_SB(1, 1), b3 + hstep, voffB);
            PG8_WAIT_V(6); PG8_BAR; PG8_MMA(1, 1, At, B1); PG8_BAR;
            }
        }
        if constexpr (ALIGN_EPI) { if (wr == 0) PG8_BAR; }
        if constexpr (!Epi::AFTER_DRAIN) { E(acc, cur, wr, wc, fr, fq); S.done(cur); }
        if (!has_next) break;
#pragma unroll
        for (int a = 0; a < 2; ++a)
#pragma unroll
            for (int b = 0; b < 2; ++b)
#pragma unroll
                for (int m = 0; m < 4; ++m)
#pragma unroll
                    for (int n = 0; n < 2; ++n) acc[a][b][m][n] = (f32x4){0.f, 0.f, 0.f, 0.f};
        cur = nxt; cA = nA; cB = nB; ++ui;
        if constexpr (ALIGN_EPI) { if (wr == 1) PG8_BAR; }
    }
    PG8_WAIT_V(0);
    if constexpr (!ALIGN_EPI) { if (wr == 0) PG8_BAR; }
    PG8_BAR;
    if constexpr (Epi::AFTER_DRAIN) { E.fused(acc, cur, wr, wc, fr, fq, lds, wid, lane); S.done(cur); }
#undef PG8_SA
#undef PG8_SB
#undef PG8_STAGE
#undef PG8_LDA
#undef PG8_LDB
#undef PG8_MMA
#undef PG8_WAIT_V
#undef PG8_WAIT_L
#undef PG8_BAR
#undef PG8_SCHED
}
}

#define DI __device__ __forceinline__
#define LAS __attribute__((address_space(3)))
typedef unsigned short bf16;
typedef unsigned v4u __attribute__((ext_vector_type(4)));
typedef unsigned v2u __attribute__((ext_vector_type(2)));
typedef float f32x4 __attribute__((ext_vector_type(4)));
typedef float f32x16 __attribute__((ext_vector_type(16)));
typedef short bf16x8 __attribute__((ext_vector_type(8)));

#ifndef PHM
#define PHM 0xFFFF
#endif
#ifndef REP
#define REP 0
#endif
constexpr int NWAVES = 8;
constexpr int S_ = 2048, D_ = 1024, NSEQ = 40, NTOK = NSEQ * S_;
constexpr int INC = 9216, C_LX = 0, C_LG = 1280, C_Q = 2560, C_K = 4096, C_V = 5632, C_GA = 7168, C_GB = 8192;
constexpr int DFF = 3072;
constexpr int PITCH = INC + 64;
constexpr float EPS_ = 1e-6f;
constexpr float QSCALE = 0.125f * 1.4426950408889634f;

constexpr size_t MiB = 1u << 20;
constexpr size_t WS_CTL = 0, CTL_BYTES = 1 * MiB;
constexpr size_t CTL_SS = 16384;
constexpr size_t WS_WIN = 1 * MiB, WS_WUP = 19 * MiB, WS_WDN = 31 * MiB, WS_WO = 37 * MiB, WS_WLO = 39 * MiB, WS_WAO = 42 * MiB, WS_WG = 43 * MiB, WS_ROPE = 44 * MiB, WS_ACT = 45 * MiB;
constexpr size_t ACT_PER_TOK = 2048 + 2048 + 18432;

constexpr int LDS_BYTES = 147456, RING_BYTES = 131072, MISC_OFF = 147456 - 256;

DI unsigned f2bf(float f) { unsigned u = __builtin_bit_cast(unsigned, f); return (u + 0x7fffu + ((u >> 16) & 1u)) >> 16; }
typedef float f32x2_t __attribute__((ext_vector_type(2))); typedef __bf16 bf16x2_t __attribute__((ext_vector_type(2)));
DI unsigned pk2(float lo, float hi) { f32x2_t v = {lo, hi}; bf16x2_t b = __builtin_convertvector(v, bf16x2_t); return __builtin_bit_cast(unsigned, b); }
DI float bflo(unsigned w) { return __uint_as_float(w << 16); }
DI float bfhi(unsigned w) { return __uint_as_float(w & 0xffff0000u); }
DI float bf1(unsigned short h) { return __uint_as_float(((unsigned)h) << 16); }
DI float frcp(float x) { return __builtin_amdgcn_rcpf(x); }
DI float sigm(float x) { return frcp(1.0f + __expf(-x)); }
DI float gelu_t(float x) { const float u = 0.7978845608028654f * (x + 0.044715f * x * x * x); return x * frcp(1.0f + __expf(-2.0f * u)); }
DI float wave_sum(float v) {
#pragma unroll
    for (int o = 1; o < 64; o <<= 1) v += __shfl_xor(v, o);
    return v;
}
DI float wave_max(float v) {
#pragma unroll
    for (int o = 1; o < 64; o <<= 1) v = fmaxf(v, __shfl_xor(v, o));
    return v;
}

struct Args { const float* in[21]; float* out; unsigned char* ws; int spc; int nch; int start[6]; int cnt[6]; };
enum { I_XP = 0, I_XS, I_N1G, I_WIN, I_LCW, I_LCB, I_LWA, I_LBA, I_LWX, I_LBX, I_LAM, I_WLO, I_QNG, I_KNG, I_WAO, I_WO, I_N2G, I_WUP, I_FCW, I_FCB, I_WDN };

#define AS4 __attribute__((address_space(4)))
struct KP { const AS4 unsigned char* p; };
DI KP kp_fresh() { const AS4 unsigned char* p = (const AS4 unsigned char*)__builtin_amdgcn_kernarg_segment_ptr(); asm volatile("" : "+s"(p)); KP k; k.p = p; return k; }
DI const float* kin(KP k, int i) { return *(const float* const AS4*)(k.p + 8 * i); }
DI float* kout(KP k) { return *(float* const AS4*)(k.p + 168); }
DI unsigned char* kws(KP k) { return *(unsigned char* const AS4*)(k.p + 176); }
DI int kspc(KP k) { return *(const AS4 int*)(k.p + 184); }
DI int knch(KP k) { return *(const AS4 int*)(k.p + 188); }
DI int kstart(KP k, int c) { return *(const AS4 int*)(k.p + 192 + 4 * c); }
DI int kcnt(KP k, int c) { return *(const AS4 int*)(k.p + 216 + 4 * c); }
DI int launder_i(int v) { asm volatile("" : "+s"(v)); return v; }
DI int launder_v(int v) { asm volatile("" : "+v"(v)); return v; }
static_assert(sizeof(Args) == 240, "Args layout");
DI void p0_transpose_item(const float* W, int K, int N, bf16* WT, const float* kscale, LAS float* scr, int item, int lane, int perm = 0) {
    const int nblk = N / 32, kb = item / nblk, nb = item % nblk, k0 = 64 * kb, n0 = 32 * nb;
#pragma unroll 8
    for (int i = 0; i < 32; ++i) { const int kk = 2 * i + (lane >> 5); float v = W[(size_t)(k0 + kk) * N + n0 + (lane & 31)]; if (kscale) v *= kscale[k0 + kk]; scr[kk * 33 + (lane & 31)] = v; }
    asm volatile("s_waitcnt lgkmcnt(0)" ::: "memory");
    const int c = lane & 7;
#pragma unroll
    for (int j = 0; j < 4; ++j) { const int n = (lane >> 3) + 8 * j; const LAS float* s = scr + (8 * c) * 33 + n;
        v4u o; o.x = pk2(s[0 * 33], s[1 * 33]); o.y = pk2(s[2 * 33], s[3 * 33]); o.z = pk2(s[4 * 33], s[5 * 33]); o.w = pk2(s[6 * 33], s[7 * 33]);
        int orow = n0 + n; if (perm == 1) { const int chn = orow % 3072; orow = 256 * (chn >> 7) + (orow >= 3072 ? 128 : 0) + (chn & 127); }
        if (perm == 2 && orow >= 2560 && orow < 5632) { const int cc = orow & 255; orow = (orow & ~255) + 128 * ((cc >> 5) & 1) + 32 * (cc >> 6) + (cc & 31); }
        *(v4u*)(WT + (size_t)orow * K + k0 + 8 * c) = o; }
    asm volatile("s_waitcnt lgkmcnt(0)" ::: "memory");
}
DI void p0_weights(KP A, LAS unsigned char* lds, int tid, int wave, int lane, int G) {
    unsigned char* ws = kws(A);
    LAS float* scr = (LAS float*)(lds + wave * 16384);
    const int gw = blockIdx.x * NWAVES + wave, NGW = G * NWAVES;
    constexpr int I_IN = 16 * 288, I_UP = 16 * 192, I_DN = 48 * 32, I_O = 16 * 32, I_LO = 20 * 32, I_AO = 8 * 32;
    constexpr int NITEMS = I_IN + I_UP + I_DN + I_O + I_LO + I_AO;
    for (int it = gw; it < NITEMS; it += NGW) {
        int r = it;
        if (r < I_IN) { p0_transpose_item(kin(A, I_WIN), 1024, 9216, (bf16*)(ws + WS_WIN), nullptr, scr, r, lane, 2); continue; } r -= I_IN;
        if (r < I_UP) { p0_transpose_item(kin(A, I_WUP), 1024, 6144, (bf16*)(ws + WS_WUP), kin(A, I_N2G), scr, r, lane, 1); continue; } r -= I_UP;
        if (r < I_DN) { p0_transpose_item(kin(A, I_WDN), 3072, 1024, (bf16*)(ws + WS_WDN), nullptr, scr, r, lane); continue; } r -= I_DN;
        if (r < I_O) { p0_transpose_item(kin(A, I_WO), 1024, 1024, (bf16*)(ws + WS_WO), nullptr, scr, r, lane); continue; } r -= I_O;
        if (r < I_LO) { p0_transpose_item(kin(A, I_WLO), 1280, 1024, (bf16*)(ws + WS_WLO), nullptr, scr, r, lane); continue; } r -= I_LO;
        p0_transpose_item(kin(A, I_WAO), 512, 1024, (bf16*)(ws + WS_WAO), nullptr, scr, r, lane);
    }
    const int gt = blockIdx.x * (NWAVES * 64) + tid, NGT = G * NWAVES * 64;
    bf16* WG = (bf16*)(ws + WS_WG);
    for (int i = gt; i < 16 * 2 * 2 * 80 * 96; i += NGT) {
        const int k = i % 96, n = (i / 96) % 80, ty = (i / (96 * 80)) & 1, dir = (i / (96 * 80 * 2)) & 1, nb = i / (96 * 80 * 4);
        float v = 0.f; if (k < 80) v = (ty ? kin(A, I_LWX) : kin(A, I_LWA))[((size_t)(dir * 16 + nb) * 80 + k) * 80 + n];
        WG[i] = (bf16)f2bf(v * 1.4426950408889634f);
    }
    float* RT = (float*)(ws + WS_ROPE);
    for (int i = gt; i < 2048 * 8; i += NGT) {
        const int pos = i >> 3, fi = i & 7;
        const double inv = fi == 0 ? 1.0 : fi == 1 ? 0.19392274474868576 : fi == 2 ? 0.03760603093086393 : fi == 3 ? 0.007292664737217109 : fi == 4 ? 0.001414213562373095 : fi == 5 ? 0.0002742481756762073 : fi == 6 ? 5.318295896944988e-05 : 1.031338537721246e-05;
        const float angf = (float)pos * (float)inv;
        const double rev = (double)angf * 0.15915494309189535; const float fr = (float)(rev - __builtin_rint(rev));
        RT[2 * i] = __builtin_amdgcn_cosf(fr); RT[2 * i + 1] = __builtin_amdgcn_sinf(fr);
    }
}
DI void p0_xn(KP A, bf16* XN, int grow0, int Tc, int wave, int lane, int G) {
    const int gw = blockIdx.x * NWAVES + wave, NGW = G * NWAVES;
    const f32x4* gp = (const f32x4*)kin(A, I_N1G) + lane;
    f32x4 g[4];
#pragma unroll
    for (int j = 0; j < 4; ++j) g[j] = gp[64 * j];
    for (int m = gw; m < Tc; m += NGW) {
        const int grow = grow0 + m; const float* xr = (grow < 65536) ? kin(A, I_XP) + (size_t)grow * 1024 : kin(A, I_XS) + (size_t)(grow - 65536) * 1024;
        const f32x4* xv = (const f32x4*)xr + lane; f32x4 v[4]; float s = 0.f;
#pragma unroll
        for (int j = 0; j < 4; ++j) { v[j] = xv[64 * j]; s += (v[j].x * v[j].x + v[j].y * v[j].y) + (v[j].z * v[j].z + v[j].w * v[j].w); }
        const float rs = __builtin_amdgcn_rsqf(wave_sum(s) * (1.0f / 1024.0f) + EPS_);
        v2u* o8 = (v2u*)(XN + (size_t)m * 1024) + lane;
#pragma unroll
        for (int j = 0; j < 4; ++j) { v2u w; w.x = pk2(v[j].x * rs * g[j].x, v[j].y * rs * g[j].y); w.y = pk2(v[j].z * rs * g[j].z, v[j].w * rs * g[j].w); o8[64 * j] = w; }
    }
}

DI void p1b_qknorm_vt(KP A, const bf16* VB, bf16* VT, int Tc, LAS unsigned char* lds, int wave, int lane, int G) {
    const int gw = blockIdx.x * NWAVES + wave, NGW = G * NWAVES;
    const float* RT = (const float*)(kws(A) + WS_ROPE);
    const int c8 = lane & 7, hv0 = lane >> 3;
    LAS unsigned short* tile = (LAS unsigned short*)(lds + wave * 16384);
    const int nseq = Tc / S_, nitems = nseq * 24 * 32;
    for (int it = gw; it < nitems; it += NGW) {
        const int u = it & 31, gh = (it >> 5) % 24, b = it / (32 * 24);
        const int grp = gh >> 3, dsh = grp * 2, dil = 1 << dsh, L = S_ >> dsh;
        const int pi0 = 64 * u, mm = pi0 / L, j0 = pi0 % L;
#pragma unroll
        for (int i = 0; i < 8; ++i) { const int r = (lane >> 3) + 8 * i;
            const v4u w = *(const v4u*)(VB + ((size_t)(b * 24 + gh) * S_ + pi0 + r) * 64 + c8 * 8);
            LAS unsigned* dst = (LAS unsigned*)(tile + r * 66 + c8 * 8); dst[0] = w.x; dst[1] = w.y; dst[2] = w.z; dst[3] = w.w; }
        asm volatile("s_waitcnt lgkmcnt(0)" ::: "memory");
#pragma unroll
        for (int i = 0; i < 8; ++i) { const int d = (lane >> 3) + 8 * i; const LAS unsigned short* s = tile + (8 * c8) * 66 + d;
            v4u o; o.x = (unsigned)s[0] | ((unsigned)s[66] << 16); o.y = (unsigned)s[2 * 66] | ((unsigned)s[3 * 66] << 16); o.z = (unsigned)s[4 * 66] | ((unsigned)s[5 * 66] << 16); o.w = (unsigned)s[6 * 66] | ((unsigned)s[7 * 66] << 16);
            *(v4u*)(VT + (((size_t)(b * 24 + gh) * 64 + (pi0 >> 5) + (c8 >> 2)) * 64 + d) * 32 + 8 * (c8 & 3)) = o; }
        asm volatile("s_waitcnt lgkmcnt(0)" ::: "memory");
    }
}

constexpr int LRU_CW = 132096;
constexpr int LRU_XR = 0, LRU_XR_SZ = 20992, LRU_XCB = 2 * LRU_XR_SZ, LRU_XCB_SZ = 24576, LRU_HST = LRU_XCB + 2 * LRU_XCB_SZ, LRU_HST_SZ = 20480;
static_assert(LRU_HST + 2 * LRU_HST_SZ <= LRU_CW && LRU_CW + 3200 <= MISC_OFF, "lru lds");
struct LruUnit { const bf16* wrp; const bf16* wip; float ba, bx, kk, hc; };
DI void lru_unit_setup(LruUnit& U, KP A, int nb, int dir, int cb, int lane) {
    const bf16* WG = (const bf16*)(kws(A) + WS_WG);
    const int n = 16 * cb + (lane & 15), kq = lane >> 4;
    U.wrp = WG + ((size_t)((nb * 2 + dir) * 2 + 0) * 80 + n) * 96 + 8 * kq;
    U.wip = WG + ((size_t)((nb * 2 + dir) * 2 + 1) * 80 + n) * 96 + 8 * kq;
    const int ch = dir * 1280 + 80 * nb + n;
    U.ba = kin(A, I_LBA)[ch] * 1.4426950408889634f; U.bx = kin(A, I_LBX)[ch] * 1.4426950408889634f;
    const float lam = kin(A, I_LAM)[ch]; const float nl = -lam; const float sp = fmaxf(nl, 0.f) + log1pf(__expf(-fabsf(nl)));
    U.kk = -8.0f * sp * 1.4426950408889634f; U.hc = 0.f;
}
DI void lru_unit_run(LruUnit& U, const bf16x8 (&wr)[3], const bf16x8 (&wi)[3], LAS unsigned char* xcb, LAS unsigned char* hst, int cb, int lane) {
    const int c = lane & 15, q = lane >> 4;
    float hc = U.hc;
#pragma unroll 1
    for (int half = 0; half < 2; ++half) {
        float av[4][4], bv[4][4], Ac[4], Bc[4];
#pragma unroll
        for (int t = 0; t < 4; ++t) {
            const int tb = 4 * half + t;
            f32x4 ar = {0.f, 0.f, 0.f, 0.f}, ai = {0.f, 0.f, 0.f, 0.f};
#pragma unroll
            for (int ks = 0; ks < 3; ++ks) {
                const bf16x8 a = *(const LAS bf16x8*)(xcb + (16 * tb + c) * 192 + (32 * ks + 8 * q) * 2);
                ar = __builtin_amdgcn_mfma_f32_16x16x32_bf16(a, wr[ks], ar, 0, 0, 0);
                ai = __builtin_amdgcn_mfma_f32_16x16x32_bf16(a, wi[ks], ai, 0, 0, 0);
            }
#pragma unroll
            for (int e = 0; e < 4; ++e) {
                const int s = 16 * tb + 4 * q + e;
                const float xc = bf1(*(const LAS unsigned short*)(xcb + s * 192 + (16 * cb + c) * 2));
                const float r = frcp(1.0f + __builtin_amdgcn_exp2f(-(ar[e] + U.ba))), ig = frcp(1.0f + __builtin_amdgcn_exp2f(-(ai[e] + U.bx)));
                const float a = __builtin_amdgcn_exp2f(U.kk * r);
                av[t][e] = a; bv[t][e] = __builtin_amdgcn_sqrtf(fmaxf(1.0f - a * a, 0.f)) * ig * xc;
            }
            Ac[t] = av[t][0] * av[t][1] * av[t][2] * av[t][3];
            Bc[t] = ((bv[t][0] * av[t][1] + bv[t][1]) * av[t][2] + bv[t][2]) * av[t][3] + bv[t][3];
        }
#pragma unroll
        for (int t = 0; t < 4; ++t) { const float A1 = __shfl_up(Ac[t], 16), B1 = __shfl_up(Bc[t], 16); if (q >= 1) { Bc[t] = Ac[t] * B1 + Bc[t]; Ac[t] = A1 * Ac[t]; } }
#pragma unroll
        for (int t = 0; t < 4; ++t) { const float A2 = __shfl_up(Ac[t], 32), B2 = __shfl_up(Bc[t], 32); if (q >= 2) { Bc[t] = Ac[t] * B2 + Bc[t]; Ac[t] = A2 * Ac[t]; } }
        float At[4], Bt[4], Ae[4], Be[4];
#pragma unroll
        for (int t = 0; t < 4; ++t) { At[t] = __shfl(Ac[t], 48 + c); Bt[t] = __shfl(Bc[t], 48 + c); Ae[t] = __shfl_up(Ac[t], 16); Be[t] = __shfl_up(Bc[t], 16); }
#pragma unroll
        for (int t = 0; t < 4; ++t) {
            const int tb = 4 * half + t;
            float h = (q == 0) ? hc : (Ae[t] * hc + Be[t]);
#pragma unroll
            for (int e = 0; e < 4; ++e) { h = av[t][e] * h + bv[t][e]; *(LAS unsigned short*)(hst + (16 * tb + 4 * q + e) * 160 + (16 * cb + c) * 2) = (unsigned short)pk2(h, 0.f); }
            hc = At[t] * hc + Bt[t];
        }
    }
    U.hc = hc;
}
#define LBAR() do { asm volatile("s_waitcnt lgkmcnt(0)" ::: "memory"); __builtin_amdgcn_s_barrier(); asm volatile("" ::: "memory"); } while (0)
DI void lru_item(KP A, const bf16* XL, const bf16* GL, bf16* HG, int b, int nb, LAS unsigned char* lds, int tid, int wave, int lane) {
    const int dir = wave >> 2, dtid = tid & 255;
    LAS unsigned char* xr = lds + LRU_XR + dir * LRU_XR_SZ;
    LAS unsigned char* xcb = lds + LRU_XCB + dir * LRU_XCB_SZ;
    LAS unsigned char* hst = lds + LRU_HST + dir * LRU_HST_SZ;
    const size_t rowbase = (size_t)b * S_;
    LruUnit U0, U1;
    const int u0 = wave, u1 = wave + 8; const bool two = wave < 2;
    lru_unit_setup(U0, A, nb, u0 / 5, u0 % 5, lane);
    lru_unit_setup(U1, A, nb, two ? u1 / 5 : 0, two ? u1 % 5 : 0, lane);
    { const int r = dtid >> 1, hf = dtid & 1; LAS v4u* z = (LAS v4u*)(xcb + r * 192 + 160 + hf * 16); *z = (v4u){0u, 0u, 0u, 0u}; }
    LAS float* cw = (LAS float*)(lds + LRU_CW + dir * 1600);
    for (int i = dtid; i < 400; i += 256) { const int j = i / 80, cc = i % 80; cw[i] = (j < 4) ? kin(A, I_LCW)[j * 1280 + 80 * nb + cc] : kin(A, I_LCB)[80 * nb + cc]; }
    {
        const int t0 = dir ? 15 * 128 : 0;
#pragma unroll
        for (int i = 0; i < 6; ++i) { const int idx = dtid + 256 * i; if (idx < 1310) { const int row = idx / 10, c8 = idx % 10; const int t = t0 - 2 + row;
            v4u w = (v4u){0u, 0u, 0u, 0u}; if (t >= 0 && t < S_) w = *(const v4u*)(XL + ((size_t)(b * 16 + nb) * S_ + t) * 80 + 8 * c8);
            *(LAS v4u*)(xr + row * 160 + c8 * 16) = w; } }
    }
    __syncthreads();
    bf16x8 w0r[3], w0i[3], w1r[3], w1i[3];
#pragma unroll
    for (int ks = 0; ks < 3; ++ks) { w0r[ks] = *(const bf16x8*)(U0.wrp + 32 * ks); w0i[ks] = *(const bf16x8*)(U0.wip + 32 * ks); w1r[ks] = *(const bf16x8*)(U1.wrp + 32 * ks); w1i[ks] = *(const bf16x8*)(U1.wip + 32 * ks); }
#pragma unroll 1
    for (int it = 0; it < 16; ++it) {
        const int ti = dir ? 15 - it : it, t0 = ti * 128;
        const bool second = it >= 8;
        v4u nx[6];
        {
            const int tn = (dir ? ti - 1 : ti + 1) * 128; const int dt = launder_v(dtid);
#pragma unroll
            for (int i = 0; i < 6; ++i) { const int idx = dt + 256 * i; const int row = idx / 10, c8 = idx % 10; const int t = tn - 2 + row;
                nx[i] = (v4u){0u, 0u, 0u, 0u}; if (it < 15 && idx < 1310 && t >= 0 && t < S_) nx[i] = *(const v4u*)(XL + ((size_t)(b * 16 + nb) * S_ + t) * 80 + 8 * c8); }
        }
        if (dtid < 250) {
            const int dt = launder_v(dtid); const int c8 = dt % 10, trow = dt / 10; const int ch = 80 * nb + 8 * c8;
            float w[4][8], bb[8];
#pragma unroll
            for (int j = 0; j < 4; ++j) { const f32x4 a0 = *(const LAS f32x4*)(cw + j * 80 + 8 * c8), a1 = *(const LAS f32x4*)(cw + j * 80 + 8 * c8 + 4);
                w[j][0] = a0.x; w[j][1] = a0.y; w[j][2] = a0.z; w[j][3] = a0.w; w[j][4] = a1.x; w[j][5] = a1.y; w[j][6] = a1.z; w[j][7] = a1.w; }
            { const f32x4 a0 = *(const LAS f32x4*)(cw + 320 + 8 * c8), a1 = *(const LAS f32x4*)(cw + 320 + 8 * c8 + 4);
                bb[0] = a0.x; bb[1] = a0.y; bb[2] = a0.z; bb[3] = a0.w; bb[4] = a1.x; bb[5] = a1.y; bb[6] = a1.z; bb[7] = a1.w; }
#pragma unroll 1
            for (int o = trow; o < 128; o += 25) {
                float acc[8];
#pragma unroll
                for (int e = 0; e < 8; ++e) acc[e] = bb[e];
#pragma unroll
                for (int j = 0; j < 4; ++j) { const v4u xw = *(const LAS v4u*)(xr + (o + j) * 160 + c8 * 16);
                    acc[0] += w[j][0] * bflo(xw.x); acc[1] += w[j][1] * bfhi(xw.x); acc[2] += w[j][2] * bflo(xw.y); acc[3] += w[j][3] * bfhi(xw.y);
                    acc[4] += w[j][4] * bflo(xw.z); acc[5] += w[j][5] * bfhi(xw.z); acc[6] += w[j][6] * bflo(xw.w); acc[7] += w[j][7] * bfhi(xw.w); }
                const int s = dir ? 127 - o : o;
                v4u ow; ow.x = pk2(acc[0], acc[1]); ow.y = pk2(acc[2], acc[3]); ow.z = pk2(acc[4], acc[5]); ow.w = pk2(acc[6], acc[7]);
                *(LAS v4u*)(xcb + s * 192 + c8 * 16) = ow;
            }
        }
        LBAR();
        v4u gt[5], pt[5];
        { const int dt = launder_v(dtid);
#pragma unroll
        for (int i = 0; i < 5; ++i) { const int idx = dt + 256 * i; const int srow = idx / 10, c8 = idx % 10; const int t = t0 + (dir ? 127 - srow : srow);
            gt[i] = (v4u){0u, 0u, 0u, 0u}; pt[i] = (v4u){0u, 0u, 0u, 0u};
            if (second) { gt[i] = *(const v4u*)(GL + ((size_t)(b * 16 + nb) * S_ + t) * 80 + 8 * c8); pt[i] = *(const v4u*)(HG + (rowbase + t) * 1280 + 80 * nb + 8 * c8); } } }
        lru_unit_run(U0, w0r, w0i, lds + LRU_XCB + (u0 / 5) * LRU_XCB_SZ, lds + LRU_HST + (u0 / 5) * LRU_HST_SZ, u0 % 5, lane);
        if (two) lru_unit_run(U1, w1r, w1i, lds + LRU_XCB + (u1 / 5) * LRU_XCB_SZ, lds + LRU_HST + (u1 / 5) * LRU_HST_SZ, u1 % 5, lane);
        LBAR();
        const int dt2 = launder_v(dtid);
#pragma unroll
        for (int i = 0; i < 5; ++i) { const int idx = dt2 + 256 * i; const int srow = idx / 10, c8 = idx % 10; const int t = t0 + (dir ? 127 - srow : srow);
            v4u hw = *(const LAS v4u*)(hst + srow * 160 + c8 * 16);
            if (second) {
                v4u o;
                o.x = pk2((bflo(hw.x) + bflo(pt[i].x)) * bflo(gt[i].x), (bfhi(hw.x) + bfhi(pt[i].x)) * bfhi(gt[i].x));
                o.y = pk2((bflo(hw.y) + bflo(pt[i].y)) * bflo(gt[i].y), (bfhi(hw.y) + bfhi(pt[i].y)) * bfhi(gt[i].y));
                o.z = pk2((bflo(hw.z) + bflo(pt[i].z)) * bflo(gt[i].z), (bfhi(hw.z) + bfhi(pt[i].z)) * bfhi(gt[i].z));
                o.w = pk2((bflo(hw.w) + bflo(pt[i].w)) * bflo(gt[i].w), (bfhi(hw.w) + bfhi(pt[i].w)) * bfhi(gt[i].w));
                hw = o;
            }
            *(v4u*)(HG + (rowbase + t) * 1280 + 80 * nb + 8 * c8) = hw; }
        const int dt3 = launder_v(dtid);
#pragma unroll
        for (int i = 0; i < 6; ++i) { const int idx = dt3 + 256 * i; if (idx < 1310) { const int row = idx / 10, c8 = idx % 10; *(LAS v4u*)(xr + row * 160 + c8 * 16) = nx[i]; } }
        if (it == 7) __syncthreads(); else LBAR();
    }
}

DI int crow(int r, int hi) { return (r & 3) + 8 * (r >> 2) + 4 * hi; }
DI int swap23(int i) { return (i & ~12) | ((i & 4) << 1) | ((i & 8) >> 1); }
DI int colx(int x) { return x ^ ((x >> 5) & 15); }
template <int NT> DI void attn_run(const bf16* QB, const bf16* KB, const bf16* VT, size_t rowbase, int b, int gh, int dil, int L, int mm, int jbase, float Mc, int jl, int hi, f32x16 (&o)[NT][2], float (&lsum)[NT]) {
    bf16x8 qf[NT][4];
#pragma unroll
    for (int t = 0; t < NT; ++t) { const bf16* qrow = QB + ((size_t)(b * 24 + gh) * S_ + mm * L + jbase + 32 * t + jl) * 64;
#pragma unroll
        for (int ks = 0; ks < 4; ++ks) qf[t][ks] = *(const bf16x8*)(qrow + 16 * ks + 8 * hi);
#pragma unroll
        for (int r = 0; r < 16; ++r) { o[t][0][r] = 0.f; o[t][1][r] = 0.f; }
        lsum[t] = 0.f; }
    const int jb = jbase >> 5;
    const int kb_lo = max(jb - 2, 0), kb_hi = min(jb + NT + 1, (L >> 5) - 1);
    const bf16* vrow0 = VT + ((size_t)(b * 24 + gh) * 64 + ((mm * L) >> 5)) * 2048 + jl * 32;
#pragma unroll 1
    for (int kb = kb_lo; kb <= kb_hi; ++kb) {
        bf16x8 kf[4], vf[2][2];
        { const int kj_ = 32 * kb + swap23(jl); const bf16* krow_ = KB + ((size_t)(b * 24 + gh) * S_ + mm * L + kj_) * 64;
#pragma unroll
          for (int ks = 0; ks < 4; ++ks) kf[ks] = *(const bf16x8*)(krow_ + 16 * ks + 8 * hi); }
#pragma unroll
        for (int mb = 0; mb < 2; ++mb)
#pragma unroll
            for (int ks = 0; ks < 2; ++ks) vf[mb][ks] = *(const bf16x8*)(vrow0 + (size_t)kb * 2048 + 1024 * mb + 16 * ks + 8 * hi);
#pragma unroll
        for (int t = 0; t < NT; ++t) {
            if (kb >= jb + t - 2 && kb <= jb + t + 2) {
                const int qj = jbase + 32 * t + jl;
                f32x16 s;
#pragma unroll
                for (int r = 0; r < 16; ++r) s[r] = 0.f;
#pragma unroll
                for (int ks = 0; ks < 4; ++ks) s = __builtin_amdgcn_mfma_f32_32x32x16_bf16(kf[ks], qf[t][ks], s, 0, 0, 0);
                float p[16];
#pragma unroll
                for (int r = 0; r < 16; ++r) { const int key = 32 * kb + swap23(crow(r, hi)); const int dj = key - qj;
                    const float pv = __builtin_amdgcn_exp2f(s[r] - Mc); p[r] = (dj <= 64 && dj >= -64) ? pv : 0.f; lsum[t] += p[r]; }
#pragma unroll
                for (int ks = 0; ks < 2; ++ks) {
                    v4u pw; pw.x = pk2(p[8 * ks + 0], p[8 * ks + 1]); pw.y = pk2(p[8 * ks + 2], p[8 * ks + 3]); pw.z = pk2(p[8 * ks + 4], p[8 * ks + 5]); pw.w = pk2(p[8 * ks + 6], p[8 * ks + 7]);
                    const bf16x8 pf = __builtin_bit_cast(bf16x8, pw);
                    o[t][0] = __builtin_amdgcn_mfma_f32_32x32x16_bf16(vf[0][ks], pf, o[t][0], 0, 0, 0);
                    o[t][1] = __builtin_amdgcn_mfma_f32_32x32x16_bf16(vf[1][ks], pf, o[t][1], 0, 0, 0);
                }
            }
        }
    }
}
DI void attn_merge(LAS float* Ot, LAS float* Ls, bool first, int x, int hi, const f32x16& o0, const f32x16& o1, float lsum) {
    lsum += __shfl_xor(lsum, 32);
    const int cx = colx(x);
    if (first) {
#pragma unroll
        for (int r = 0; r < 16; ++r) { Ot[crow(r, hi) * 512 + cx] = o0[r]; Ot[(32 + crow(r, hi)) * 512 + cx] = o1[r]; }
        if (hi == 0) Ls[x] = lsum;
    } else {
#pragma unroll
        for (int r = 0; r < 16; ++r) { Ot[crow(r, hi) * 512 + cx] += o0[r]; Ot[(32 + crow(r, hi)) * 512 + cx] += o1[r]; }
        if (hi == 0) Ls[x] += lsum;
    }
}
DI void attn_unit(KP A, const bf16* QB, const bf16* KB, const bf16* VT, bf16* OA, int b, int h, int pb, LAS unsigned char* lds, int tid, int wave, int lane) {
    LAS float* Ot = (LAS float*)lds;
    LAS float* Ls = (LAS float*)(lds + 131072);
    const size_t rowbase = (size_t)b * S_;
    const int P = 512 * pb;
#pragma unroll 1
    for (int g = 0; g < 3; ++g) {
        const int ln_ = launder_v(lane); const int jl = ln_ & 31, hi = ln_ >> 5;
        const int dsh = 2 * g, dil = 1 << dsh, L = S_ >> dsh;
        const int gh = g * 8 + h;
        float mq = fabsf(kin(A, I_QNG)[g * 64 + ln_]), mk = fabsf(kin(A, I_KNG)[g * 64 + ln_]);
        mq = wave_max(mq); mk = wave_max(mk);
        const float Mc = 8.0f * mq * mk * 1.4426950408889634f;
        if (g < 2) {
            int mm, jbase, xa, xb;
            if (g == 0) { mm = 0; jbase = P + 64 * wave; xa = 64 * wave + jl; xb = xa + 32; }
            else { mm = wave & 3; const int jp = wave >> 2; jbase = (P >> 2) + 64 * jp; xa = 4 * (64 * jp + jl) + mm; xb = xa + 128; }
            f32x16 o[2][2]; float ls[2];
            attn_run<2>(QB, KB, VT, rowbase, b, gh, dil, L, mm, jbase, Mc, jl, hi, o, ls);
            attn_merge(Ot, Ls, g == 0, xa, hi, o[0][0], o[0][1], ls[0]);
            attn_merge(Ot, Ls, g == 0, xb, hi, o[1][0], o[1][1], ls[1]);
        } else {
#pragma unroll 1
            for (int sl = 0; sl < 2; ++sl) {
                const int mm = 2 * wave + sl, jbase = P >> 4, x = 16 * jl + mm;
                f32x16 o[1][2]; float ls[1];
                attn_run<1>(QB, KB, VT, rowbase, b, gh, dil, L, mm, jbase, Mc, jl, hi, o, ls);
                attn_merge(Ot, Ls, false, x, hi, o[0][0], o[0][1], ls[0]);
            }
        }
        __syncthreads();
    }
    {
        const int x = launder_v(tid), cx = colx(x);
        const float inv = 1.0f / Ls[x];
        bf16* orow = OA + (rowbase + P + x) * 512 + h * 64;
#pragma unroll
        for (int c = 0; c < 8; ++c) { float v[8];
#pragma unroll
            for (int e = 0; e < 8; ++e) v[e] = Ot[(8 * c + e) * 512 + cx] * inv;
            v4u w; w.x = pk2(v[0], v[1]); w.y = pk2(v[2], v[3]); w.z = pk2(v[4], v[5]); w.w = pk2(v[6], v[7]);
            *(v4u*)(orow + 8 * c) = w; }
    }
    __syncthreads();
}

DI void p4b_ffn_act(KP A, const bf16* UP, bf16* H, int Tc, int tid, int G) {
    const int gt = blockIdx.x * (NWAVES * 64) + tid, NGT = G * NWAVES * 64;
    const int nitems = (Tc / 8) * 384;
    for (int it = gt; it < nitems; it += NGT) {
        const int cc = it % 384, tg = it / 384; const int ch = 8 * cc; const int t0 = 8 * tg; const int pos0 = t0 & (S_ - 1);
        float w0[8], w1[8], w2[8], bb[8];
        { const float* p = kin(A, I_FCW) + ch; const f32x4 a0 = *(const f32x4*)p, a1 = *(const f32x4*)(p + 4), b0 = *(const f32x4*)(p + DFF), b1 = *(const f32x4*)(p + DFF + 4), c0 = *(const f32x4*)(p + 2 * DFF), c1 = *(const f32x4*)(p + 2 * DFF + 4);
          const f32x4 d0 = *(const f32x4*)(kin(A, I_FCB) + ch), d1 = *(const f32x4*)(kin(A, I_FCB) + ch + 4);
#pragma unroll
          for (int e = 0; e < 4; ++e) { w0[e] = a0[e]; w0[e + 4] = a1[e]; w1[e] = b0[e]; w1[e + 4] = b1[e]; w2[e] = c0[e]; w2[e + 4] = c1[e]; bb[e] = d0[e]; bb[e + 4] = d1[e]; } }
        const bf16* gp = UP + (size_t)t0 * 6144 + ch;
        float gm[8], gc[8], gn[8];
        { v4u w = (v4u){0u, 0u, 0u, 0u}; if (pos0 != 0) w = *(const v4u*)(gp - 6144);
          gm[0] = bflo(w.x); gm[1] = bfhi(w.x); gm[2] = bflo(w.y); gm[3] = bfhi(w.y); gm[4] = bflo(w.z); gm[5] = bfhi(w.z); gm[6] = bflo(w.w); gm[7] = bfhi(w.w); }
        { const v4u w = *(const v4u*)gp;
          gc[0] = bflo(w.x); gc[1] = bfhi(w.x); gc[2] = bflo(w.y); gc[3] = bfhi(w.y); gc[4] = bflo(w.z); gc[5] = bfhi(w.z); gc[6] = bflo(w.w); gc[7] = bfhi(w.w); }
#pragma unroll
        for (int i = 0; i < 8; ++i) {
            v4u w = (v4u){0u, 0u, 0u, 0u}; if (i < 7 || pos0 + 8 < S_) w = *(const v4u*)(gp + (size_t)(i + 1) * 6144);
            gn[0] = bflo(w.x); gn[1] = bfhi(w.x); gn[2] = bflo(w.y); gn[3] = bfhi(w.y); gn[4] = bflo(w.z); gn[5] = bfhi(w.z); gn[6] = bflo(w.w); gn[7] = bfhi(w.w);
            const v4u vw = *(const v4u*)(gp + (size_t)i * 6144 + DFF);
            const float vv[8] = {bflo(vw.x), bfhi(vw.x), bflo(vw.y), bfhi(vw.y), bflo(vw.z), bfhi(vw.z), bflo(vw.w), bfhi(vw.w)};
            float o[8];
#pragma unroll
            for (int e = 0; e < 8; ++e) { const float pre = bb[e] + w0[e] * gm[e] + w1[e] * gc[e] + w2[e] * gn[e]; o[e] = gelu_t(pre) * vv[e]; gm[e] = gc[e]; gc[e] = gn[e]; }
            v4u ow; ow.x = pk2(o[0], o[1]); ow.y = pk2(o[2], o[3]); ow.z = pk2(o[4], o[5]); ow.w = pk2(o[6], o[7]);
            *(v4u*)(H + (size_t)(t0 + i) * DFF + ch) = ow;
        }
    }
}

DI void p4c_fixup(KP A, const float* SB, bf16* H, int Tc, int tid, int G) {
    const int gt = blockIdx.x * (NWAVES * 64) + tid, NGT = G * NWAVES * 64;
    const int nedge = (Tc / 256) * 8, nitems = nedge * 768;
    for (int it = gt; it < nitems; it += NGT) {
        const int c4 = it % 768, e = it / 768; const int ch = 4 * c4;
        const int last = e & 1, run = (e >> 1) & 3, tile = e >> 3; const int row = tile * 256 + run * 64 + (last ? 63 : 0); const int pos = row & (S_ - 1);
        const float* sb = SB + (size_t)e * 9216 + ch;
        f32x4 pre = *(const f32x4*)(sb + 3072); const f32x4 v = *(const f32x4*)(sb + 6144);
        if (!last && pos != 0) { const f32x4 gnb = *(const f32x4*)(sb - 9216); const f32x4 w0 = *(const f32x4*)(kin(A, I_FCW) + ch); pre = pre + w0 * gnb; }
        if (last && pos != S_ - 1) { const f32x4 gnb = *(const f32x4*)(sb + 9216); const f32x4 w2 = *(const f32x4*)(kin(A, I_FCW) + 2 * DFF + ch); pre = pre + w2 * gnb; }
        v2u w; w.x = pk2(gelu_t(pre[0]) * v[0], gelu_t(pre[1]) * v[1]); w.y = pk2(gelu_t(pre[2]) * v[2], gelu_t(pre[3]) * v[3]);
        *(v2u*)(H + (size_t)row * DFF + ch) = w;
    }
}

#define XB_TMO      128
#define XB_XCNT(j)  (256  + 64 * (j))
#define XB_XSUB(j)  (1280 + 64 * (j))
#define XB_XGEN(j)  (2304 + 64 * (j))
#define XB_TOP      3328
#define XB_TOPGEN   3392
#define XCD_BAR_WORDS 3456
#define XB_SPIN_CAP (1u << 18)

__device__ __forceinline__ unsigned xb_ld(unsigned* p)              { return __hip_atomic_load(p, __ATOMIC_RELAXED, __HIP_MEMORY_SCOPE_AGENT); }
__device__ __forceinline__ unsigned xb_add(unsigned* p, unsigned v) { return __hip_atomic_fetch_add(p, v, __ATOMIC_RELAXED, __HIP_MEMORY_SCOPE_AGENT); }
__device__ __forceinline__ unsigned xb_xcc_id() { return (unsigned)__builtin_amdgcn_s_getreg((3 << 11) | 20) & 0xFu; }
#define XB_SPIN(cond, bar) do { unsigned _sp = 0; while (cond) { __builtin_amdgcn_s_sleep(1); \
    if ((++_sp & 255u) == 0u) { if (xb_ld(&(bar)[XB_TMO])) break; if (_sp > XB_SPIN_CAP) { atomicAdd(&(bar)[XB_TMO], 1u); break; } } } } while (0)

struct XcdBarrier {
    unsigned* bar; unsigned x;
    volatile LAS unsigned* st;
};

__device__ __forceinline__ XcdBarrier xcd_barrier_post(unsigned* bar, volatile LAS unsigned* st) {
    XcdBarrier b; b.bar = bar; b.x = xb_xcc_id(); b.st = st;
    if (threadIdx.x == 0) (void)xb_add(&bar[XB_XCNT(b.x)], 1u);
    return b;
}
__device__ __forceinline__ void xcd_barrier_complete(unsigned* bar, unsigned x, unsigned& nloc, unsigned& nx) {
    const unsigned G = gridDim.x * gridDim.y * gridDim.z;
    unsigned sum, cnt, mine, sp = 0u;
    for (;;) {
        sum = 0u; cnt = 0u; mine = 0u;
#pragma unroll
        for (unsigned j = 0; j < 16; ++j) { const unsigned c = xb_ld(&bar[XB_XCNT(j)]); sum += c; cnt += (c > 0u) ? 1u : 0u; mine = (j == x) ? c : mine; }
        if (sum == G) break;
        __builtin_amdgcn_s_sleep(1);
        if ((++sp & 255u) == 0u) { if (xb_ld(&bar[XB_TMO])) break; if (sp > XB_SPIN_CAP) { atomicAdd(&bar[XB_TMO], 1u); break; } }
    }
    nloc = mine > 0u ? mine : 1u; nx = cnt > 0u ? cnt : 1u;
}

__device__ __forceinline__ void xcd_barrier(const XcdBarrier& b) {
    asm volatile("s_waitcnt vmcnt(0)" ::: "memory");
    __syncthreads();
    if (threadIdx.x == 0) {
        unsigned* bar = b.bar;
        __builtin_amdgcn_s_waitcnt(0);
        unsigned nloc = b.st[0], nx = b.st[1];
        if (nloc == 0u) { xcd_barrier_complete(bar, b.x, nloc, nx); b.st[0] = nloc; b.st[1] = nx; }
        const unsigned old = xb_add(&bar[XB_XSUB(b.x)], 1u);
        const unsigned gen = old / nloc;
        if (old + 1u == (gen + 1u) * nloc) {
            __builtin_amdgcn_fence(__ATOMIC_RELEASE, "agent");
            asm volatile("s_waitcnt vmcnt(0)" ::: "memory");
            const unsigned og = xb_add(&bar[XB_TOP], 1u);
            const unsigned tg = og / nx;
            if (og + 1u == (tg + 1u) * nx) xb_add(&bar[XB_TOPGEN], 1u);
            else XB_SPIN(xb_ld(&bar[XB_TOPGEN]) == tg, bar);
            __builtin_amdgcn_fence(__ATOMIC_ACQUIRE, "agent");
            xb_add(&bar[XB_XGEN(b.x)], 1u);
            asm volatile("s_waitcnt vmcnt(0)" ::: "memory");
        } else {
            XB_SPIN(xb_ld(&bar[XB_XGEN(b.x)]) == gen, bar);
            __builtin_amdgcn_fence(__ATOMIC_ACQUIRE, "agent");
            asm volatile("s_waitcnt vmcnt(0)" ::: "memory");
        }
    }
    __syncthreads();
}

constexpr size_t CTL_BAR = 512 * 1024;
DI void grid_bar_cg() { cg::this_grid().sync(); }
DI void grid_bar(LAS unsigned char* lds) {
    const KP k = kp_fresh();
    XcdBarrier b; b.bar = (unsigned*)(kws(k) + WS_CTL + CTL_BAR); b.x = xb_xcc_id(); b.st = (volatile LAS unsigned*)(lds + MISC_OFF + 32);
    xcd_barrier(b);
}
struct Ctx { int Tc, grow0, G; unsigned char* ws; bf16 *XN, *MG, *PROJ, *H, *HG, *OA, *XL, *GL, *QB, *KB, *VB, *GT; float* out; float* SS; };
DI Ctx make_ctx(KP k, int c) {
    Ctx X; const int Tm = kspc(k) * S_; X.Tc = kcnt(k, c) * S_; X.grow0 = kstart(k, c) * S_; X.G = gridDim.x; X.ws = kws(k); X.out = kout(k);
    X.SS = (float*)(X.ws + WS_CTL + CTL_SS);
    X.XN = (bf16*)(X.ws + WS_ACT); X.MG = (bf16*)(X.ws + WS_ACT + (size_t)Tm * 2048); X.PROJ = (bf16*)(X.ws + WS_ACT + (size_t)Tm * 4096);
    X.H = (bf16*)(X.ws + WS_ACT + (size_t)Tm * 4096 + (size_t)Tm * 12288);
    { unsigned char* rg = (unsigned char*)X.PROJ; X.XL = (bf16*)rg; X.GL = (bf16*)(rg + (size_t)Tm * 2560); X.QB = (bf16*)(rg + (size_t)Tm * 5120); X.KB = (bf16*)(rg + (size_t)Tm * 8192); X.VB = (bf16*)(rg + (size_t)Tm * 11264); X.GT = (bf16*)(rg + (size_t)Tm * 14336); }
    X.HG = (bf16*)(X.out + (size_t)X.grow0 * 1024); X.OA = (bf16*)((unsigned char*)X.HG + (size_t)X.Tc * 2560);
    return X;
}
#define PH_PRE(c) const int tid = launder_v(threadIdx.x), lane = tid & 63, wave = __builtin_amdgcn_readfirstlane(tid >> 6); (void)lane; (void)wave; const KP k = kp_fresh(); const Ctx X = make_ctx(k, launder_i(c));
DI void ph_p0(LAS unsigned char* lds) { PH_PRE(0) p0_weights(k, lds, tid, wave, lane, X.G); p0_xn(k, X.XN, X.grow0, X.Tc, wave, lane, X.G); }
DI void ph_p1(LAS unsigned char* lds, int c) { PH_PRE(c)
    pg8::Gemm g{(c == 0) ? X.XN : X.MG, (const bf16*)(X.ws + WS_WIN), X.Tc, INC, 1024}; pg8::StaticOrder S; S.init(X.Tc, INC, X.G, launder_i((int)blockIdx.x));
    pg8::EpiProj E{X.XL, X.GL, X.QB, X.KB, X.VB, X.GT, (const float*)(X.ws + WS_ROPE), kin(k, I_QNG), kin(k, I_KNG), QSCALE};
    pg8::gemm_phase<pg8::EpiProj, pg8::StaticOrder, true, true>(lds, g, S, E); }
DI void ph_p1b(LAS unsigned char* lds, int c) { PH_PRE(c) p1b_qknorm_vt(k, X.VB, X.XN, X.Tc, lds, wave, lane, X.G); }
constexpr size_t CTL_Q = 768 * 1024;
DI void ph_p2(LAS unsigned char* lds, int c, int cslot, int what) { PH_PRE(c)
    volatile LAS int* misc = (volatile LAS int*)(lds + MISC_OFF);
    unsigned* qh = (unsigned*)(X.ws + WS_CTL + CTL_Q) + 64 * 8 * cslot;
    const int spc = X.Tc / S_;
    const int n_lru8 = spc * 2, n_att8 = spc * 4, total8 = n_lru8 + n_att8;
    const int myx = (int)(xb_xcc_id() & 7u);
#pragma unroll 1
    for (int hop = 0; hop < 8; ++hop) {
        const int xq = (myx + hop) & 7;
        for (;;) {
            if (tid == 0) misc[0] = (int)atomicAdd(qh + 64 * xq, 1u);
            __syncthreads();
            const int q = misc[0];
            __syncthreads();
            if (q >= total8) break;
            if (q < n_lru8) { const int item = xq + 8 * q; if (what & 1) lru_item(k, X.XL, X.GL, X.HG, item / 16, item % 16, lds, tid, wave, lane); }
            else if (what & 2) { const int qa = q - n_lru8; const int bh = xq + 8 * (qa >> 2), pb = qa & 3; attn_unit(k, X.QB, X.KB, X.XN, X.OA, bh >> 3, bh & 7, pb, lds, tid, wave, lane); }
        }
    } }
DI void ph_p3a1(LAS unsigned char* lds, int c) { PH_PRE(c)
    pg8::Gemm g{X.HG, (const bf16*)(X.ws + WS_WLO), X.Tc, 1024, 1280}; pg8::StaticOrder S; S.init(X.Tc, 1024, X.G, launder_i((int)blockIdx.x));
    pg8::EpiMerge<false> E{X.MG, (const unsigned char*)X.GT, 2048};
    pg8::gemm_phase<pg8::EpiMerge<false>, pg8::StaticOrder, true, true>(lds, g, S, E); }
DI void ph_p3a2(LAS unsigned char* lds, int c) { PH_PRE(c)
    pg8::Gemm g{X.OA, (const bf16*)(X.ws + WS_WAO), X.Tc, 1024, 512}; pg8::StaticOrder S; S.init(X.Tc, 1024, X.G, launder_i((int)blockIdx.x));
    pg8::EpiMerge<true> E{X.MG, (const unsigned char*)X.GT + 1024, 2048};
    pg8::gemm_phase<pg8::EpiMerge<true>, pg8::StaticOrder, true, true>(lds, g, S, E); }
DI void ph_p3b(LAS unsigned char* lds, int c) { PH_PRE(c)
    pg8::Gemm g{X.MG, (const bf16*)(X.ws + WS_WO), X.Tc, 1024, 1024}; pg8::StaticOrder S; S.init(X.Tc, 1024, X.G, launder_i((int)blockIdx.x));
    pg8::EpiWo E{kin(k, I_XP), kin(k, I_XS), X.out, X.XN, X.SS, X.grow0};
    pg8::gemm_phase<pg8::EpiWo, pg8::StaticOrder, true, true>(lds, g, S, E); }
DI void ph_p4(LAS unsigned char* lds, int c) { PH_PRE(c)
    pg8::Gemm g{X.XN, (const bf16*)(X.ws + WS_WUP), X.Tc, 6144, 1024}; pg8::StaticOrder S; S.init(X.Tc, 6144, X.G, launder_i((int)blockIdx.x));
    pg8::EpiUpFused E{X.H, X.SS, X.grow0, kin(k, I_FCW), kin(k, I_FCB), (float*)X.PROJ};
    pg8::gemm_phase<pg8::EpiUpFused, pg8::StaticOrder, true, true>(lds, g, S, E); }
DI void ph_p4b(LAS unsigned char* lds, int c) { PH_PRE(c) p4c_fixup(k, (const float*)X.PROJ, X.H, X.Tc, tid, X.G); }
DI void ph_p5(LAS unsigned char* lds, int c) { PH_PRE(c)
    pg8::Gemm g{X.H, (const bf16*)(X.ws + WS_WDN), X.Tc, 1024, 3072}; pg8::StaticOrder S; S.init(X.Tc, 1024, X.G, launder_i((int)blockIdx.x));
    pg8::EpiDown E{X.out, X.XN, X.grow0};
    pg8::gemm_phase<pg8::EpiDown, pg8::StaticOrder, true, true>(lds, g, S, E); }
DI void ph_xn_next(LAS unsigned char* lds, int c) { PH_PRE(c) p0_xn(k, X.MG, kstart(k, c + 1) * S_, kcnt(k, c + 1) * S_, wave, lane, X.G); }

__global__ void __launch_bounds__(NWAVES * 64, 2) hybrid_fwd(Args args) {
    extern __shared__ __attribute__((aligned(16))) unsigned char lds_raw[];
    LAS unsigned char* lds = (LAS unsigned char*)lds_raw;
    const int nchunks = args.nch;
    { volatile LAS unsigned* st = (volatile LAS unsigned*)(lds + MISC_OFF); if (threadIdx.x < 64) st[threadIdx.x] = 0u; __syncthreads();
      (void)xcd_barrier_post((unsigned*)(args.ws + WS_CTL + CTL_BAR), (volatile LAS unsigned*)(lds + MISC_OFF + 32)); }
    if (PHM & 1) ph_p0(lds);
    if (REP & 1) { grid_bar_cg(); ph_p0(lds); }
    cg::this_grid().sync();
#pragma unroll 1
    for (int c = 0; c < nchunks; ++c) {
        if (PHM & 2) ph_p1(lds, c);
        grid_bar(lds);
        if (REP & 2) { ph_p1(lds, c); grid_bar(lds); }
        if (PHM & 4) ph_p1b(lds, c);
        grid_bar(lds);
        if (REP & 4) { ph_p1b(lds, c); grid_bar(lds); }
        ph_p2(lds, c, c, 3);
        grid_bar(lds);
        if (REP & 8) { ph_p2(lds, c, c + 8, 3); grid_bar(lds); }
        if (REP & 16) { ph_p2(lds, c, c + 16, 1); grid_bar(lds); }
        if (REP & 32768) { ph_p2(lds, c, c + 24, 2); grid_bar(lds); }
        if (PHM & 32) ph_p3a1(lds, c);
        if (PHM & 64) ph_p3a2(lds, c);
        grid_bar(lds);
        if (REP & 32) { ph_p3a1(lds, c); ph_p3a2(lds, c); grid_bar(lds); }
        if (PHM & 128) ph_p3b(lds, c);
        grid_bar(lds);
        if (PHM & 256) ph_p4(lds, c);
        grid_bar(lds);
        if (REP & 256) { ph_p4(lds, c); grid_bar(lds); }
        if (PHM & 512) ph_p4b(lds, c);
        grid_bar(lds);
        if (REP & 512) { ph_p4b(lds, c); grid_bar(lds); }
        if (PHM & 1024) ph_p5(lds, c);
        if (c + 1 < nchunks) { if (PHM & 1) ph_xn_next(lds, c); grid_bar(lds); }
    }
}

extern "C" void kernel_launch(void* const* d_in, const int* in_sizes, int n_in, void* d_out, int out_size, void* d_ws, size_t ws_size, hipStream_t stream) {
    static int grid = 0, spc = 0;
    if (grid == 0) {
        int dev = 0, cus = 0, per_cu = 0;
        if (hipGetDevice(&dev) != hipSuccess || hipDeviceGetAttribute(&cus, hipDeviceAttributeMultiprocessorCount, dev) != hipSuccess) { fprintf(stderr, "kernel_launch: device query failed\n"); grid = -1; return; }
        if (hipFuncSetAttribute((const void*)hybrid_fwd, hipFuncAttributeMaxDynamicSharedMemorySize, LDS_BYTES) != hipSuccess) { fprintf(stderr, "kernel_launch: hipFuncSetAttribute failed\n"); grid = -1; return; }
        if (hipOccupancyMaxActiveBlocksPerMultiprocessor(&per_cu, (const void*)hybrid_fwd, NWAVES * 64, LDS_BYTES) != hipSuccess || per_cu < 1) { fprintf(stderr, "kernel_launch: occupancy query gives %d\n", per_cu); per_cu = 1; }
        (void)hipGetLastError();
        grid = cus;
        const int cand[8] = {16, 10, 8, 5, 4, 2, 1, 0};
        for (int i = 0; cand[i]; ++i) if (WS_ACT + (size_t)cand[i] * S_ * ACT_PER_TOK <= ws_size) { spc = cand[i]; break; }
        if (spc == 0) { fprintf(stderr, "kernel_launch: workspace too small (%zu)\n", ws_size); grid = -1; return; }
        fprintf(stderr, "kernel_launch: grid %d, per_cu %d, spc %d, ws %zu\n", grid, per_cu, spc, ws_size);
    }
    if (grid < 0) return;
    (void)hipMemsetAsync((char*)d_ws + WS_CTL, 0, CTL_BYTES, stream);
    Args a{};
    for (int i = 0; i < 21; ++i) a.in[i] = (const float*)d_in[i];
    a.out = (float*)d_out; a.ws = (unsigned char*)d_ws; a.spc = spc;
    { int st = 0, n = 0; while (st < NSEQ && n < 6) { const int m = (NSEQ - st < spc) ? NSEQ - st : spc; a.start[n] = st; a.cnt[n] = m; st += m; ++n; } a.nch = n;
      if (st < NSEQ) { fprintf(stderr, "kernel_launch: too many chunks\n"); return; } }
    void* kargs[] = {&a};
    hipError_t e = hipLaunchCooperativeKernel((const void*)hybrid_fwd, dim3(grid), dim3(NWAVES * 64), kargs, LDS_BYTES, stream);
    if (e != hipSuccess) fprintf(stderr, "kernel_launch: cooperative launch failed: %s (grid %d)\n", hipGetErrorString(e), grid);
}
```

```cpp
#include <hip/hip_runtime.h>
#include <hip/hip_cooperative_groups.h>
#include <cstdio>
#include <cstdint>
namespace cg = cooperative_groups;
namespace pg8 {
#define PG8_LAS __attribute__((address_space(3)))
typedef unsigned short bf16_t;
typedef short bf16x8 __attribute__((ext_vector_type(8)));
typedef float f32x4 __attribute__((ext_vector_type(4)));
typedef unsigned u32x4 __attribute__((ext_vector_type(4)));
constexpr int BM = 256, BK = 64, HALF = 128, HTB = HALF * BK * 2  , STAGE_BYTES = 8 * HTB, NXCD = 8, WGM = 8;

__host__ __device__ __forceinline__ int lds_byte(int r, int c) { const int st = (r >> 4) * 2 + (c >> 5), rr = r & 15, cc = c & 31, ob = rr * 64 + cc * 2; return st * 1024 + (ob ^ (((ob >> 9) & 1) << 5)); }
__host__ __device__ __forceinline__ void stage_rc(int b, int& R, int& C) { const int st = b / 1024, sb = b % 1024, swz = sb ^ (((sb >> 9) & 1) << 5); R = (st >> 1) * 16 + swz / 64; C = (st & 1) * 32 + (swz % 64) / 2; }
__host__ __device__ __forceinline__ int perm32(int rho) { const int n = rho >> 4, i = rho & 15; return 8 * (i >> 2) + 4 * n + (i & 3); }

struct Unit { int pm, pn; };
struct Gemm { const bf16_t* A; const bf16_t* Bt; int M, N, K; };

struct StaticOrder {
    int nM, nN, nwg, G, c;
    __host__ __device__ void init(int M, int N, int G_, int c_) { nM = M / BM; nN = N / BM; nwg = nM * nN; G = G_; c = c_; }
    __host__ __device__ bool next(int i, Unit& u) const {
        const long L = (long)i * G + c; if (L >= nwg) return false;
        int wgid = (int)L; { const int q = nwg / NXCD, r = nwg % NXCD, xcd = wgid % NXCD, off = wgid / NXCD; wgid = (xcd < r ? xcd * (q + 1) : r * (q + 1) + (xcd - r) * q) + off; }
        const int nig = WGM * nN, gid = wgid / nig, fm = gid * WGM, gsz = (nM - fm) < WGM ? (nM - fm) : WGM;
        u.pm = fm + ((wgid % nig) % gsz); u.pn = (wgid % nig) / gsz; return true;
    }
    __device__ __forceinline__ void a_ready(const Unit&) const {}
    __device__ __forceinline__ void done(const Unit&) const {}
};

__device__ __forceinline__ unsigned cvt_pk_bf16(float lo, float hi) { unsigned r; asm volatile("v_cvt_pk_bf16_f32 %0, %1, %2" : "=v"(r) : "v"(lo), "v"(hi)); return r; }
typedef float f32x2 __attribute__((ext_vector_type(2)));
typedef unsigned u32x2 __attribute__((ext_vector_type(2)));
__device__ __forceinline__ float fast_rcp(float x) { return __builtin_amdgcn_rcpf(x); }
__device__ __forceinline__ float sigmoid_f(float x) { return fast_rcp(1.0f + __expf(-x)); }
__device__ __forceinline__ float gelu_tanh_f(float x) { const float u = 0.7978845608028654f * (x + 0.044715f * x * x * x); return x * fast_rcp(1.0f + __expf(-2.0f * u)); }
__device__ __forceinline__ float bf_lo(unsigned w) { return __uint_as_float(w << 16); }
__device__ __forceinline__ float bf_hi(unsigned w) { return __uint_as_float(w & 0xffff0000u); }

struct EpiProj {
    static constexpr bool PERM = true, AFTER_DRAIN = false;
    bf16_t *XL, *GL, *QB, *KB, *VB, *GT; const float* RT; const float* qg; const float* kg; float qscale;
    __device__ __forceinline__ static int permpos(int t, int g) { const int dsh = 2 * g; return (t & ((1 << dsh) - 1)) * (2048 >> dsh) + (t >> dsh); }
    __device__ __forceinline__ void operator()(const f32x4 (&acc)[2][2][4][2], const Unit& u, int wr, int wc, int fr, int fq) const {
        const int colt = u.pn * BM;
        const int row0 = u.pm * BM + wr * 64 + fr;
        if (colt >= 2560 && colt < 5632) {
            const bool isk = colt >= 4096; const int cb0 = colt - (isk ? 4096 : 2560); const int grp = cb0 >> 9; const int gh = (cb0 >> 6) + wc;
            const float* gp = (isk ? kg : qg) + grp * 64 + 8 * fq;
            f32x4 gn[2][2];
#pragma unroll
            for (int bj = 0; bj < 2; ++bj)
#pragma unroll
                for (int n = 0; n < 2; ++n) gn[bj][n] = *(const f32x4*)(gp + 32 * bj + 4 * n);
            const float sc = isk ? 1.0f : qscale;
            bf16_t* OB = isk ? KB : QB;
#pragma unroll
            for (int ai = 0; ai < 2; ++ai)
#pragma unroll
                for (int m = 0; m < 4; ++m) { const int lrow = row0 + ai * HALF + m * 16; const int pos = lrow & 2047, bb = lrow >> 11;
                    f32x4 y[2][2]; float ss = 0.f;
#pragma unroll
                    for (int bj = 0; bj < 2; ++bj)
#pragma unroll
                        for (int n = 0; n < 2; ++n) { y[bj][n] = acc[ai][bj][m][n]; ss += (y[bj][n][0] * y[bj][n][0] + y[bj][n][1] * y[bj][n][1]) + (y[bj][n][2] * y[bj][n][2] + y[bj][n][3] * y[bj][n][3]); }
                    ss += __shfl_xor(ss, 16); ss += __shfl_xor(ss, 32);
                    const float rs = __builtin_amdgcn_rsqf(ss * (1.0f / 64.0f) + 1e-6f);
#pragma unroll
                    for (int bj = 0; bj < 2; ++bj)
#pragma unroll
                        for (int n = 0; n < 2; ++n) y[bj][n] = y[bj][n] * gn[bj][n] * rs;
#pragma unroll
                    for (int n = 0; n < 2; ++n) { f32x4 pr;
#pragma unroll
                        for (int e = 0; e < 4; ++e) pr[e] = __shfl_xor(y[0][n][e], 16);
                        if (fq < 2) { const f32x4 t0 = *(const f32x4*)(RT + (size_t)pos * 16 + 8 * n), t1 = *(const f32x4*)(RT + (size_t)pos * 16 + 8 * n + 4);
                            const float co[4] = {t0[0], t0[2], t1[0], t1[2]}, si[4] = {t0[1], t0[3], t1[1], t1[3]};
#pragma unroll
                            for (int e = 0; e < 4; ++e) y[0][n][e] = (fq == 0) ? (y[0][n][e] * co[e] - pr[e] * si[e]) : (y[0][n][e] * co[e] + pr[e] * si[e]); } }
                    bf16_t* rowp = OB + ((size_t)(bb * 24 + gh) * 2048 + permpos(pos, grp)) * 64 + 8 * fq;
#pragma unroll
                    for (int bj = 0; bj < 2; ++bj) { const f32x4 v0 = y[bj][0] * sc, v1 = y[bj][1] * sc;
                        u32x4 w; w.x = cvt_pk_bf16(v0[0], v0[1]); w.y = cvt_pk_bf16(v0[2], v0[3]); w.z = cvt_pk_bf16(v1[0], v1[1]); w.w = cvt_pk_bf16(v1[2], v1[3]);
                        *(u32x4*)(rowp + 32 * bj) = w; }
                    asm volatile("" ::: "memory"); }
            return;
        }
        const int mode = (colt >= 7168) ? 2 : ((colt >= 1280 && colt < 2560) ? 1 : 0);
        const int col0 = colt + wc * 32 + 8 * fq;
#pragma unroll
        for (int ai = 0; ai < 2; ++ai)
#pragma unroll
            for (int m = 0; m < 4; ++m) { const int lrow = row0 + ai * HALF + m * 16; const int pos = lrow & 2047, bb = lrow >> 11;
#pragma unroll
                for (int bj = 0; bj < 2; ++bj) { f32x4 v0 = acc[ai][bj][m][0], v1 = acc[ai][bj][m][1];
                    const int col = col0 + bj * HALF; bf16_t* dst;
                    if (colt < 2560) { const int cc = col - (mode == 1 ? 1280 : 0); const int nb = cc / 80, c = cc - nb * 80; dst = (mode == 1 ? GL : XL) + ((size_t)(bb * 16 + nb) * 2048 + pos) * 80 + c; }
                    else if (colt < 7168) { const int cv = col - 5632; const int gh = cv >> 6; dst = VB + ((size_t)(bb * 24 + gh) * 2048 + permpos(pos, gh >> 3)) * 64 + (cv & 63); }
                    else dst = GT + (size_t)lrow * 2048 + (col - 7168);
                    if (mode == 1) {
#pragma unroll
                        for (int e = 0; e < 4; ++e) { v0[e] = gelu_tanh_f(v0[e]); v1[e] = gelu_tanh_f(v1[e]); } }
                    else if (mode == 2) {
                        unsigned q[8];
#pragma unroll
                        for (int e = 0; e < 4; ++e) { q[e] = (unsigned)(sigmoid_f(v0[e]) * 255.0f + 0.5f); q[4 + e] = (unsigned)(sigmoid_f(v1[e]) * 255.0f + 0.5f); }
                        u32x2 wq; wq.x = q[0] | (q[1] << 8) | (q[2] << 16) | (q[3] << 24); wq.y = q[4] | (q[5] << 8) | (q[6] << 16) | (q[7] << 24);
                        *(u32x2*)((unsigned char*)GT + (size_t)lrow * 2048 + (col - 7168)) = wq;
                        continue; }
                    u32x4 w; w.x = cvt_pk_bf16(v0[0], v0[1]); w.y = cvt_pk_bf16(v0[2], v0[3]); w.z = cvt_pk_bf16(v1[0], v1[1]); w.w = cvt_pk_bf16(v1[2], v1[3]);
                    *(u32x4*)dst = w; } }
    }
};
template <bool SECOND> struct EpiMerge {
    static constexpr bool PERM = true, AFTER_DRAIN = false;
    bf16_t* MG; const unsigned char* G; int ldg;
    __device__ __forceinline__ void operator()(const f32x4 (&acc)[2][2][4][2], const Unit& u, int wr, int wc, int fr, int fq) const {
        const int row0 = u.pm * BM + wr * 64 + fr, col0 = u.pn * BM + wc * 32 + 8 * fq;
#pragma unroll
        for (int ai = 0; ai < 2; ++ai)
#pragma unroll
            for (int m = 0; m < 4; ++m) { const size_t row = (size_t)(row0 + ai * HALF + m * 16);
#pragma unroll
                for (int bj = 0; bj < 2; ++bj) { const f32x4 v0 = acc[ai][bj][m][0], v1 = acc[ai][bj][m][1];
                    const u32x2 g = *(const u32x2*)(G + row * ldg + col0 + bj * HALF);
                    float o[8]; const float k255 = 1.0f / 255.0f;
                    o[0] = v0[0] * ((float)(g.x & 0xffu) * k255); o[1] = v0[1] * ((float)((g.x >> 8) & 0xffu) * k255); o[2] = v0[2] * ((float)((g.x >> 16) & 0xffu) * k255); o[3] = v0[3] * ((float)(g.x >> 24) * k255);
                    o[4] = v1[0] * ((float)(g.y & 0xffu) * k255); o[5] = v1[1] * ((float)((g.y >> 8) & 0xffu) * k255); o[6] = v1[2] * ((float)((g.y >> 16) & 0xffu) * k255); o[7] = v1[3] * ((float)(g.y >> 24) * k255);
                    bf16_t* dst = MG + row * 1024 + col0 + bj * HALF;
                    if (SECOND) { const u32x4 p = *(const u32x4*)dst;
                        o[0] += bf_lo(p.x); o[1] += bf_hi(p.x); o[2] += bf_lo(p.y); o[3] += bf_hi(p.y); o[4] += bf_lo(p.z); o[5] += bf_hi(p.z); o[6] += bf_lo(p.w); o[7] += bf_hi(p.w); }
                    u32x4 w; w.x = cvt_pk_bf16(o[0], o[1]); w.y = cvt_pk_bf16(o[2], o[3]); w.z = cvt_pk_bf16(o[4], o[5]); w.w = cvt_pk_bf16(o[6], o[7]);
                    *(u32x4*)dst = w; } }
    }
};
struct EpiWo {
    static constexpr bool PERM = false, AFTER_DRAIN = false;
    const float* xp; const float* xs; float* OUT; bf16_t* XB; float* SS; int grow0;
    __device__ __forceinline__ void operator()(const f32x4 (&acc)[2][2][4][2], const Unit& u, int wr, int wc, int fr, int fq) const {
        const int row0 = u.pm * BM + wr * 64 + fr, col0 = u.pn * BM + wc * 32 + 4 * fq;
#pragma unroll
        for (int ai = 0; ai < 2; ++ai)
#pragma unroll
            for (int m = 0; m < 4; ++m) { const int lrow = row0 + ai * HALF + m * 16; const int grow = grow0 + lrow;
                const float* xr = (grow < 65536) ? xp + (size_t)grow * 1024 : xs + (size_t)(grow - 65536) * 1024;
                bf16_t* brow = XB + (size_t)lrow * 1024; float ss = 0.f;
#pragma unroll
                for (int bj = 0; bj < 2; ++bj)
#pragma unroll
                    for (int n = 0; n < 2; ++n) { const int c = col0 + bj * HALF + n * 16; const f32x4 xv = *(const f32x4*)(xr + c); const f32x4 o = xv + acc[ai][bj][m][n];
                        ss += (o[0] * o[0] + o[1] * o[1]) + (o[2] * o[2] + o[3] * o[3]);
                        u32x2 w; w.x = cvt_pk_bf16(o[0], o[1]); w.y = cvt_pk_bf16(o[2], o[3]); *(u32x2*)(brow + c) = w; }
                ss += __shfl_xor(ss, 16); ss += __shfl_xor(ss, 32);
                if (fq == 0) atomicAdd(SS + grow, ss); }
    }
};
struct EpiUp {
    static constexpr bool PERM = true, AFTER_DRAIN = false;
    bf16_t* O; const float* SS; int grow0;
    __device__ __forceinline__ void operator()(const f32x4 (&acc)[2][2][4][2], const Unit& u, int wr, int wc, int fr, int fq) const {
        const int row0 = u.pm * BM + wr * 64 + fr, col0 = u.pn * BM + wc * 32 + 8 * fq;
#pragma unroll
        for (int ai = 0; ai < 2; ++ai)
#pragma unroll
            for (int m = 0; m < 4; ++m) { const int lrow = row0 + ai * HALF + m * 16; const float rs = __builtin_amdgcn_rsqf(SS[grow0 + lrow] * (1.0f / 1024.0f) + 1e-6f);
                bf16_t* rowp = O + (size_t)lrow * 6144 + col0;
#pragma unroll
                for (int bj = 0; bj < 2; ++bj) { const f32x4 v0 = acc[ai][bj][m][0] * rs, v1 = acc[ai][bj][m][1] * rs;
                    u32x4 w; w.x = cvt_pk_bf16(v0[0], v0[1]); w.y = cvt_pk_bf16(v0[2], v0[3]); w.z = cvt_pk_bf16(v1[0], v1[1]); w.w = cvt_pk_bf16(v1[2], v1[3]);
                    *(u32x4*)(rowp + bj * HALF) = w; }
                asm volatile("" ::: "memory"); }
    }
};
struct EpiUpFused {
    static constexpr bool PERM = true, AFTER_DRAIN = false;
    bf16_t* H; const float* SS; int grow0; const float* cw; const float* cb; float* SB;
    __device__ __forceinline__ void operator()(const f32x4 (&acc)[2][2][4][2], const Unit& u, int wr, int wc, int fr, int fq) const {
        const int lane = fq * 16 + fr, srcP = (lane & 48) | ((fr + 15) & 15), srcN = (lane & 48) | ((fr + 1) & 15);
        const int row0 = u.pm * BM + wr * 64 + fr, ch0 = u.pn * HALF + wc * 32 + 8 * fq;
#pragma unroll
        for (int ai = 0; ai < 2; ++ai) {
            float rs[4];
#pragma unroll
            for (int m = 0; m < 4; ++m) rs[m] = __builtin_amdgcn_rsqf(SS[grow0 + row0 + ai * HALF + m * 16] * (1.0f / 1024.0f) + 1e-6f);
            const int er = ((u.pm * 4 + 2 * ai + wr) * 2) * 9216;
#pragma unroll
            for (int n = 0; n < 2; ++n) {
                const int ch = ch0 + 4 * n;
                const f32x4 w0 = *(const f32x4*)(cw + ch), w1 = *(const f32x4*)(cw + 3072 + ch), w2 = *(const f32x4*)(cw + 6144 + ch), bb = *(const f32x4*)(cb + ch);
                float o[4][4], pp[4][4], gg[4][4];
#pragma unroll
                for (int e = 0; e < 4; ++e) {
                    float g[4], R[4], L[4];
#pragma unroll
                    for (int m = 0; m < 4; ++m) { g[m] = acc[ai][0][m][n][e] * rs[m]; R[m] = __shfl(g[m], srcP); L[m] = __shfl(g[m], srcN); }
#pragma unroll
                    for (int m = 0; m < 4; ++m) {
                        const float gp = (fr == 0) ? (m > 0 ? R[m > 0 ? m - 1 : 0] : 0.f) : R[m];
                        const float gn = (fr == 15) ? (m < 3 ? L[m < 3 ? m + 1 : 3] : 0.f) : L[m];
                        const float pre = bb[e] + w0[e] * gp + w1[e] * g[m] + w2[e] * gn;
                        pp[m][e] = pre; gg[m][e] = g[m];
                        o[m][e] = gelu_tanh_f(pre) * (acc[ai][1][m][n][e] * rs[m]);
                    }
                }
#pragma unroll
                for (int m = 0; m < 4; ++m) {
                    const bool edge = (m == 0 && fr == 0) || (m == 3 && fr == 15);
                    if (!edge) { u32x2 w; w.x = cvt_pk_bf16(o[m][0], o[m][1]); w.y = cvt_pk_bf16(o[m][2], o[m][3]); *(u32x2*)(H + (size_t)(row0 + ai * HALF + m * 16) * 3072 + ch) = w; }
                }
                if (fr == 0) { float* sb = SB + er + ch;
                    *(f32x4*)(sb) = (f32x4){gg[0][0], gg[0][1], gg[0][2], gg[0][3]}; *(f32x4*)(sb + 3072) = (f32x4){pp[0][0], pp[0][1], pp[0][2], pp[0][3]};
                    *(f32x4*)(sb + 6144) = (f32x4){acc[ai][1][0][n][0] * rs[0], acc[ai][1][0][n][1] * rs[0], acc[ai][1][0][n][2] * rs[0], acc[ai][1][0][n][3] * rs[0]}; }
                if (fr == 15) { float* sb = SB + er + 9216 + ch;
                    *(f32x4*)(sb) = (f32x4){gg[3][0], gg[3][1], gg[3][2], gg[3][3]}; *(f32x4*)(sb + 3072) = (f32x4){pp[3][0], pp[3][1], pp[3][2], pp[3][3]};
                    *(f32x4*)(sb + 6144) = (f32x4){acc[ai][1][3][n][0] * rs[3], acc[ai][1][3][n][1] * rs[3], acc[ai][1][3][n][2] * rs[3], acc[ai][1][3][n][3] * rs[3]}; }
            }
            asm volatile("" ::: "memory");
        }
    }
};
struct EpiDown {
    static constexpr bool PERM = false, AFTER_DRAIN = false;
    float* OUT; const bf16_t* XB; int grow0;
    __device__ __forceinline__ void operator()(const f32x4 (&acc)[2][2][4][2], const Unit& u, int wr, int wc, int fr, int fq) const {
        const int row0 = u.pm * BM + wr * 64 + fr, col0 = u.pn * BM + wc * 32 + 4 * fq;
#pragma unroll
        for (int ai = 0; ai < 2; ++ai)
#pragma unroll
            for (int m = 0; m < 4; ++m) { const int lrow = row0 + ai * HALF + m * 16; float* orow = OUT + (size_t)(grow0 + lrow) * 1024; const bf16_t* brow = XB + (size_t)lrow * 1024;
#pragma unroll
                for (int bj = 0; bj < 2; ++bj)
#pragma unroll
                    for (int n = 0; n < 2; ++n) { const int c = col0 + bj * HALF + n * 16; const u32x2 xw = *(const u32x2*)(brow + c);
                        const f32x4 xv = (f32x4){bf_lo(xw.x), bf_hi(xw.x), bf_lo(xw.y), bf_hi(xw.y)}; *(f32x4*)(orow + c) = xv + acc[ai][bj][m][n]; } }
    }
};
template <class Epi, class Sched, bool ALIGN_EPI = false, bool SP2 = false>
__device__ __forceinline__ void gemm_phase(PG8_LAS unsigned char* lds, const Gemm g, const Sched& S, const Epi& E) {
    int tid_ = threadIdx.x; asm volatile("" : "+v"(tid_));
    const int tid = tid_, wid = __builtin_amdgcn_readfirstlane(tid >> 6), lane = tid & 63, wr = wid >> 2, wc = wid & 3, fr = lane & 15, fq = lane >> 4;
    const int K = g.K, nt = K / BK;
    unsigned voffA[2], voffB[2];
#pragma unroll
    for (int i = 0; i < 2; ++i) { int R, C; stage_rc(tid * 16 + i * 8192, R, C); const int Rb = Epi::PERM ? ((R & ~31) + perm32(R & 31)) : R;
        voffA[i] = (unsigned)(R * K + C) * 2u; voffB[i] = (unsigned)(Rb * K + C) * 2u; }
    const size_t kstep = (size_t)(BK * 2);
    const size_t hstep = (size_t)HALF * K * 2;
    const size_t tstep = 2 * hstep;
    const unsigned ldsw = (unsigned)wid * 1024u;
    const int aoff = lds_byte(wr * 64 + fr, fq * 8), boff = lds_byte(wc * 32 + fr, fq * 8);
#define PG8_SA(b, h) (((b) * 2 + (h)) * HTB)
#define PG8_SB(b, h) ((4 + (b) * 2 + (h)) * HTB)
#define PG8_STAGE(bufoff, gbase, voff) do { _Pragma("unroll") for (int _i = 0; _i < 2; ++_i) \
        __builtin_amdgcn_global_load_lds((const unsigned*)((const char*)(gbase) + (voff)[_i]), (PG8_LAS unsigned*)(lds + (bufoff) + ldsw + _i * 8192), 16, 0, 0); } while (0)
#define PG8_LDA(dst, b, h) do { _Pragma("unroll") for (int m = 0; m < 4; ++m) _Pragma("unroll") for (int k = 0; k < 2; ++k) dst[m][k] = *(const PG8_LAS bf16x8*)(lds + PG8_SA(b, h) + aoff + m * 2048 + k * 1024); } while (0)
#define PG8_LDB(dst, b, h) do { _Pragma("unroll") for (int n = 0; n < 2; ++n) _Pragma("unroll") for (int k = 0; k < 2; ++k) dst[n][k] = *(const PG8_LAS bf16x8*)(lds + PG8_SB(b, h) + boff + n * 2048 + k * 1024); } while (0)
#define PG8_MMA(ai, bj, At, Bt) do { __builtin_amdgcn_s_setprio(1); _Pragma("unroll") for (int m = 0; m < 4; ++m) _Pragma("unroll") for (int n = 0; n < 2; ++n) _Pragma("unroll") for (int k = 0; k < 2; ++k) \
        acc[ai][bj][m][n] = __builtin_amdgcn_mfma_f32_16x16x32_bf16(Bt[n][k], At[m][k], acc[ai][bj][m][n], 0, 0, 0); __builtin_amdgcn_s_setprio(0); } while (0)
#define PG8_WAIT_V(n) asm volatile("s_waitcnt vmcnt(" #n ")" ::: "memory")
#define PG8_WAIT_L(n) asm volatile("s_waitcnt lgkmcnt(" #n ")" ::: "memory")
#define PG8_BAR __builtin_amdgcn_s_barrier()
#define PG8_SCHED __builtin_amdgcn_sched_barrier(0)
    Unit cur, nxt; int ui = 0;
    if (!S.next(0, cur)) return;
    f32x4 acc[2][2][4][2];
#pragma unroll
    for (int a = 0; a < 2; ++a)
#pragma unroll
        for (int b = 0; b < 2; ++b)
#pragma unroll
            for (int m = 0; m < 4; ++m)
#pragma unroll
                for (int n = 0; n < 2; ++n) acc[a][b][m][n] = (f32x4){0.f, 0.f, 0.f, 0.f};
    bf16x8 At[4][2], B0[2][2], B1[2][2];
    const char* cA = (const char*)g.A + (size_t)cur.pm * tstep; const char* cB = (const char*)g.Bt + (size_t)cur.pn * tstep;
    S.a_ready(cur);
    if constexpr (SP2) {
        PG8_STAGE(PG8_SB(0, 0), cB, voffB); PG8_STAGE(PG8_SB(0, 1), cB + hstep, voffB); PG8_STAGE(PG8_SA(0, 0), cA, voffA); PG8_STAGE(PG8_SA(0, 1), cA + hstep, voffA);
        if (wr == 1) PG8_BAR;
        PG8_WAIT_V(2); PG8_BAR;
        PG8_STAGE(PG8_SB(1, 0), cB + kstep, voffB); PG8_STAGE(PG8_SA(1, 0), cA + kstep, voffA); PG8_STAGE(PG8_SB(1, 1), cB + hstep + kstep, voffB);
        PG8_WAIT_V(6); PG8_BAR;
    } else {
        PG8_STAGE(PG8_SB(0, 0), cB, voffB); PG8_STAGE(PG8_SA(0, 0), cA, voffA); PG8_STAGE(PG8_SB(0, 1), cB + hstep, voffB); PG8_STAGE(PG8_SA(0, 1), cA + hstep, voffA);
        if (wr == 1) PG8_BAR;
        PG8_WAIT_V(4); PG8_BAR;
        PG8_STAGE(PG8_SB(1, 0), cB + kstep, voffB); PG8_STAGE(PG8_SA(1, 0), cA + kstep, voffA); PG8_STAGE(PG8_SB(1, 1), cB + hstep + kstep, voffB);
        PG8_WAIT_V(6); PG8_BAR;
    }
    for (;;) {
        const bool has_next = S.next(ui + 1, nxt);
        const char* nA = has_next ? (const char*)g.A + (size_t)nxt.pm * tstep : cA; const char* nB = has_next ? (const char*)g.Bt + (size_t)nxt.pn * tstep : cB;
        for (int t = 0; t < nt; t += 2) {
            const bool last = (t == nt - 2);
            const char* a1 = cA + (size_t)(t + 1) * kstep;
            const char* a2 = last ? nA : cA + (size_t)(t + 2) * kstep; const char* b2 = last ? nB : cB + (size_t)(t + 2) * kstep;
            const char* a3 = a2 + kstep; const char* b3 = b2 + kstep;
            if (last && has_next) S.a_ready(nxt);
            if constexpr (SP2) {
            PG8_LDB(B0, 0, 0); PG8_LDB(B1, 0, 1); PG8_SCHED; PG8_LDA(At, 0, 0); PG8_STAGE(PG8_SA(1, 1), a1 + hstep, voffA);
            PG8_WAIT_V(8); PG8_WAIT_L(0); PG8_BAR; PG8_MMA(0, 0, At, B0); PG8_MMA(0, 1, At, B1); PG8_BAR; PG8_SCHED;
            PG8_LDA(At, 0, 1); PG8_STAGE(PG8_SB(0, 0), b2, voffB); PG8_STAGE(PG8_SB(0, 1), b2 + hstep, voffB); PG8_STAGE(PG8_SA(0, 0), a2, voffA);
            PG8_WAIT_V(8); PG8_WAIT_L(0); PG8_BAR; PG8_MMA(1, 0, At, B0); PG8_MMA(1, 1, At, B1); PG8_BAR; PG8_SCHED;
            PG8_LDB(B0, 1, 0); PG8_LDB(B1, 1, 1); PG8_SCHED; PG8_LDA(At, 1, 0); PG8_STAGE(PG8_SA(0, 1), a2 + hstep, voffA);
            PG8_WAIT_V(8); PG8_WAIT_L(0); PG8_BAR; PG8_MMA(0, 0, At, B0); PG8_MMA(0, 1, At, B1); PG8_BAR; PG8_SCHED;
            PG8_LDA(At, 1, 1); PG8_STAGE(PG8_SB(1, 0), b3, voffB); PG8_STAGE(PG8_SB(1, 1), b3 + hstep, voffB); PG8_STAGE(PG8_SA(1, 0), a3, voffA);
            PG8_WAIT_V(8); PG8_WAIT_L(0); PG8_BAR; PG8_MMA(1, 0, At, B0); PG8_MMA(1, 1, At, B1); PG8_BAR; PG8_SCHED;
            } else {
            PG8_LDB(B0, 0, 0); PG8_SCHED; PG8_LDA(At, 0, 0); PG8_STAGE(PG8_SA(1, 1), a1 + hstep, voffA);
            PG8_WAIT_L(8); PG8_BAR; PG8_WAIT_L(0); PG8_MMA(0, 0, At, B0); PG8_BAR; PG8_SCHED;
            PG8_LDB(B1, 0, 1); PG8_STAGE(PG8_SB(0, 0), b2, voffB);
            PG8_BAR; PG8_WAIT_L(0); PG8_MMA(0, 1, At, B1); PG8_BAR;
            PG8_LDA(At, 0, 1); PG8_STAGE(PG8_SA(0, 0), a2, voffA);
            PG8_BAR; PG8_WAIT_L(0); PG8_MMA(1, 0, At, B0); PG8_BAR; PG8_SCHED;
            PG8_STAGE(PG8_SB(0, 1), b2 + hstep, voffB);
            PG8_WAIT_V(6); PG8_BAR; PG8_MMA(1, 1, At, B1); PG8_BAR;
            PG8_LDB(B0, 1, 0); PG8_SCHED; PG8_LDA(At, 1, 0); PG8_STAGE(PG8_SA(0, 1), a2 + hstep, voffA);
            PG8_WAIT_L(8); PG8_BAR; PG8_WAIT_L(0); PG8_MMA(0, 0, At, B0); PG8_BAR; PG8_SCHED;
            PG8_LDB(B1, 1, 1); PG8_STAGE(PG8_SB(1, 0), b3, voffB);
            PG8_BAR; PG8_WAIT_L(0); PG8_MMA(0, 1, At, B1); PG8_BAR;
            PG8_LDA(At, 1, 1); PG8_STAGE(PG8_SA(1, 0), a3, voffA);
            PG8_BAR; PG8_WAIT_L(0); PG8_MMA(1, 0, At, B0); PG8_BAR; PG8_SCHED;
            PG8_STAGE(PG8_SB(1, 1), b3 + hstep, voffB);
            PG8_WAIT_V(6); PG8_BAR; PG8_MMA(1, 1, At, B1); PG8_BAR;
            }
        }
        if constexpr (ALIGN_EPI) { if (wr == 0) PG8_BAR; }
        if constexpr (!Epi::AFTER_DRAIN) { E(acc, cur, wr, wc, fr, fq); S.done(cur); }
        if (!has_next) break;
#pragma unroll
        for (int a = 0; a < 2; ++a)
#pragma unroll
            for (int b = 0; b < 2; ++b)
#pragma unroll
                for (int m = 0; m < 4; ++m)
#pragma unroll
                    for (int n = 0; n < 2; ++n) acc[a][b][m][n] = (f32x4){0.f, 0.f, 0.f, 0.f};
        cur = nxt; cA = nA; cB = nB; ++ui;
        if constexpr (ALIGN_EPI) { if (wr == 1) PG8_BAR; }
    }
    PG8_WAIT_V(0);
    if constexpr (!ALIGN_EPI) { if (wr == 0) PG8_BAR; }
    PG8_BAR;
    if constexpr (Epi::AFTER_DRAIN) { E.fused(acc, cur, wr, wc, fr, fq, lds, wid, lane); S.done(cur); }
#undef PG8_SA
#undef PG8_SB
#undef PG8_STAGE
#undef PG8_LDA
#undef PG8_LDB
#undef PG8_MMA
#undef PG8_WAIT_V
#undef PG8_WAIT_L
#undef PG8_BAR
#undef PG8_SCHED
}
}

#define DI __device__ __forceinline__
#define LAS __attribute__((address_space(3)))
typedef unsigned short bf16;
typedef unsigned v4u __attribute__((ext_vector_type(4)));
typedef unsigned v2u __attribute__((ext_vector_type(2)));
typedef float f32x4 __attribute__((ext_vector_type(4)));
typedef float f32x16 __attribute__((ext_vector_type(16)));
typedef short bf16x8 __attribute__((ext_vector_type(8)));

#ifndef PHM
#define PHM 0xFFFF
#endif
#ifndef REP
#define REP 0
#endif
constexpr int NWAVES = 8;
constexpr int S_ = 2048, D_ = 1024, NSEQ = 40, NTOK = NSEQ * S_;
constexpr int INC = 9216, C_LX = 0, C_LG = 1280, C_Q = 2560, C_K = 4096, C_V = 5632, C_GA = 7168, C_GB = 8192;
constexpr int DFF = 3072;
constexpr int PITCH = INC + 64;
constexpr float EPS_ = 1e-6f;
constexpr float QSCALE = 0.125f * 1.4426950408889634f;

constexpr size_t MiB = 1u << 20;
constexpr size_t WS_CTL = 0, CTL_BYTES = 1 * MiB;
constexpr size_t CTL_SS = 16384;
constexpr size_t WS_WIN = 1 * MiB, WS_WUP = 19 * MiB, WS_WDN = 31 * MiB, WS_WO = 37 * MiB, WS_WLO = 39 * MiB, WS_WAO = 42 * MiB, WS_WG = 43 * MiB, WS_ROPE = 44 * MiB, WS_ACT = 45 * MiB;
constexpr size_t ACT_PER_TOK = 2048 + 2048 + 16384;

constexpr int LDS_BYTES = 147456, RING_BYTES = 131072, MISC_OFF = 147456 - 256;

DI unsigned f2bf(float f) { unsigned u = __builtin_bit_cast(unsigned, f); return (u + 0x7fffu + ((u >> 16) & 1u)) >> 16; }
typedef float f32x2_t __attribute__((ext_vector_type(2))); typedef __bf16 bf16x2_t __attribute__((ext_vector_type(2)));
DI unsigned pk2(float lo, float hi) { f32x2_t v = {lo, hi}; bf16x2_t b = __builtin_convertvector(v, bf16x2_t); return __builtin_bit_cast(unsigned, b); }
DI float bflo(unsigned w) { return __uint_as_float(w << 16); }
DI float bfhi(unsigned w) { return __uint_as_float(w & 0xffff0000u); }
DI float bf1(unsigned short h) { return __uint_as_float(((unsigned)h) << 16); }
DI float frcp(float x) { return __builtin_amdgcn_rcpf(x); }
DI float sigm(float x) { return frcp(1.0f + __expf(-x)); }
DI float gelu_t(float x) { const float u = 0.7978845608028654f * (x + 0.044715f * x * x * x); return x * frcp(1.0f + __expf(-2.0f * u)); }
DI float wave_sum(float v) {
#pragma unroll
    for (int o = 1; o < 64; o <<= 1) v += __shfl_xor(v, o);
    return v;
}
DI float wave_max(float v) {
#pragma unroll
    for (int o = 1; o < 64; o <<= 1) v = fmaxf(v, __shfl_xor(v, o));
    return v;
}

struct Args { const float* in[21]; float* out; unsigned char* ws; int spc; int nch; int start[6]; int cnt[6]; };
enum { I_XP = 0, I_XS, I_N1G, I_WIN, I_LCW, I_LCB, I_LWA, I_LBA, I_LWX, I_LBX, I_LAM, I_WLO, I_QNG, I_KNG, I_WAO, I_WO, I_N2G, I_WUP, I_FCW, I_FCB, I_WDN };

#define AS4 __attribute__((address_space(4)))
struct KP { const AS4 unsigned char* p; };
DI KP kp_fresh() { const AS4 unsigned char* p = (const AS4 unsigned char*)__builtin_amdgcn_kernarg_segment_ptr(); asm volatile("" : "+s"(p)); KP k; k.p = p; return k; }
DI const float* kin(KP k, int i) { return *(const float* const AS4*)(k.p + 8 * i); }
DI float* kout(KP k) { return *(float* const AS4*)(k.p + 168); }
DI unsigned char* kws(KP k) { return *(unsigned char* const AS4*)(k.p + 176); }
DI int kspc(KP k) { return *(const AS4 int*)(k.p + 184); }
DI int knch(KP k) { return *(const AS4 int*)(k.p + 188); }
DI int kstart(KP k, int c) { return *(const AS4 int*)(k.p + 192 + 4 * c); }
DI int kcnt(KP k, int c) { return *(const AS4 int*)(k.p + 216 + 4 * c); }
DI int launder_i(int v) { asm volatile("" : "+s"(v)); return v; }
DI int launder_v(int v) { asm volatile("" : "+v"(v)); return v; }
static_assert(sizeof(Args) == 240, "Args layout");
DI void p0_transpose_item(const float* W, int K, int N, bf16* WT, const float* kscale, LAS float* scr, int item, int lane, int perm = 0) {
    const int nblk = N / 32, kb = item / nblk, nb = item % nblk, k0 = 64 * kb, n0 = 32 * nb;
#pragma unroll 8
    for (int i = 0; i < 32; ++i) { const int kk = 2 * i + (lane >> 5); float v = W[(size_t)(k0 + kk) * N + n0 + (lane & 31)]; if (kscale) v *= kscale[k0 + kk]; scr[kk * 33 + (lane & 31)] = v; }
    asm volatile("s_waitcnt lgkmcnt(0)" ::: "memory");
    const int c = lane & 7;
#pragma unroll
    for (int j = 0; j < 4; ++j) { const int n = (lane >> 3) + 8 * j; const LAS float* s = scr + (8 * c) * 33 + n;
        v4u o; o.x = pk2(s[0 * 33], s[1 * 33]); o.y = pk2(s[2 * 33], s[3 * 33]); o.z = pk2(s[4 * 33], s[5 * 33]); o.w = pk2(s[6 * 33], s[7 * 33]);
        int orow = n0 + n; if (perm == 1) { const int chn = orow % 3072; orow = 256 * (chn >> 7) + (orow >= 3072 ? 128 : 0) + (chn & 127); }
        if (perm == 2 && orow >= 2560 && orow < 5632) { const int cc = orow & 255; orow = (orow & ~255) + 128 * ((cc >> 5) & 1) + 32 * (cc >> 6) + (cc & 31); }
        *(v4u*)(WT + (size_t)orow * K + k0 + 8 * c) = o; }
    asm volatile("s_waitcnt lgkmcnt(0)" ::: "memory");
}
DI void p0_weights(KP A, LAS unsigned char* lds, int tid, int wave, int lane, int G) {
    unsigned char* ws = kws(A);
    LAS float* scr = (LAS float*)(lds + wave * 16384);
    const int gw = blockIdx.x * NWAVES + wave, NGW = G * NWAVES;
    constexpr int I_IN = 16 * 288, I_UP = 16 * 192, I_DN = 48 * 32, I_O = 16 * 32, I_LO = 20 * 32, I_AO = 8 * 32;
    constexpr int NITEMS = I_IN + I_UP + I_DN + I_O + I_LO + I_AO;
    for (int it = gw; it < NITEMS; it += NGW) {
        int r = it;
        if (r < I_IN) { p0_transpose_item(kin(A, I_WIN), 1024, 9216, (bf16*)(ws + WS_WIN), nullptr, scr, r, lane, 2); continue; } r -= I_IN;
        if (r < I_UP) { p0_transpose_item(kin(A, I_WUP), 1024, 6144, (bf16*)(ws + WS_WUP), kin(A, I_N2G), scr, r, lane, 1); continue; } r -= I_UP;
        if (r < I_DN) { p0_transpose_item(kin(A, I_WDN), 3072, 1024, (bf16*)(ws + WS_WDN), nullptr, scr, r, lane); continue; } r -= I_DN;
        if (r < I_O) { p0_transpose_item(kin(A, I_WO), 1024, 1024, (bf16*)(ws + WS_WO), nullptr, scr, r, lane); continue; } r -= I_O;
        if (r < I_LO) { p0_transpose_item(kin(A, I_WLO), 1280, 1024, (bf16*)(ws + WS_WLO), nullptr, scr, r, lane); continue; } r -= I_LO;
        p0_transpose_item(kin(A, I_WAO), 512, 1024, (bf16*)(ws + WS_WAO), nullptr, scr, r, lane);
    }
    const int gt = blockIdx.x * (NWAVES * 64) + tid, NGT = G * NWAVES * 64;
    bf16* WG = (bf16*)(ws + WS_WG);
    for (int i = gt; i < 16 * 2 * 2 * 80 * 96; i += NGT) {
        const int k = i % 96, n = (i / 96) % 80, ty = (i / (96 * 80)) & 1, dir = (i / (96 * 80 * 2)) & 1, nb = i / (96 * 80 * 4);
        float v = 0.f; if (k < 80) v = (ty ? kin(A, I_LWX) : kin(A, I_LWA))[((size_t)(dir * 16 + nb) * 80 + k) * 80 + n];
        WG[i] = (bf16)f2bf(v * 1.4426950408889634f);
    }
    float* RT = (float*)(ws + WS_ROPE);
    for (int i = gt; i < 2048 * 8; i += NGT) {
        const int pos = i >> 3, fi = i & 7;
        const double inv = fi == 0 ? 1.0 : fi == 1 ? 0.19392274474868576 : fi == 2 ? 0.03760603093086393 : fi == 3 ? 0.007292664737217109 : fi == 4 ? 0.001414213562373095 : fi == 5 ? 0.0002742481756762073 : fi == 6 ? 5.318295896944988e-05 : 1.031338537721246e-05;
        const float angf = (float)pos * (float)inv;
        const double rev = (double)angf * 0.15915494309189535; const float fr = (float)(rev - __builtin_rint(rev));
        RT[2 * i] = __builtin_amdgcn_cosf(fr); RT[2 * i + 1] = __builtin_amdgcn_sinf(fr);
    }
}
DI void p0_xn(KP A, bf16* XN, int grow0, int Tc, int wave, int lane, int G) {
    const int gw = blockIdx.x * NWAVES + wave, NGW = G * NWAVES;
    const f32x4* gp = (const f32x4*)kin(A, I_N1G) + lane;
    f32x4 g[4];
#pragma unroll
    for (int j = 0; j < 4; ++j) g[j] = gp[64 * j];
    for (int m = gw; m < Tc; m += NGW) {
        const int grow = grow0 + m; const float* xr = (grow < 65536) ? kin(A, I_XP) + (size_t)grow * 1024 : kin(A, I_XS) + (size_t)(grow - 65536) * 1024;
        const f32x4* xv = (const f32x4*)xr + lane; f32x4 v[4]; float s = 0.f;
#pragma unroll
        for (int j = 0; j < 4; ++j) { v[j] = xv[64 * j]; s += (v[j].x * v[j].x + v[j].y * v[j].y) + (v[j].z * v[j].z + v[j].w * v[j].w); }
        const float rs = __builtin_amdgcn_rsqf(wave_sum(s) * (1.0f / 1024.0f) + EPS_);
        v2u* o8 = (v2u*)(XN + (size_t)m * 1024) + lane;
#pragma unroll
        for (int j = 0; j < 4; ++j) { v2u w; w.x = pk2(v[j].x * rs * g[j].x, v[j].y * rs * g[j].y); w.y = pk2(v[j].z * rs * g[j].z, v[j].w * rs * g[j].w); o8[64 * j] = w; }
    }
}

DI void p1b_qknorm_vt(KP A, const bf16* VB, bf16* VT, int Tc, LAS unsigned char* lds, int wave, int lane, int G) {
    const int gw = blockIdx.x * NWAVES + wave, NGW = G * NWAVES;
    const float* RT = (const float*)(kws(A) + WS_ROPE);
    const int c8 = lane & 7, hv0 = lane >> 3;
    LAS unsigned short* tile = (LAS unsigned short*)(lds + wave * 16384);
    const int nseq = Tc / S_, nitems = nseq * 24 * 32;
    for (int it = gw; it < nitems; it += NGW) {
        const int u = it & 31, gh = (it >> 5) % 24, b = it / (32 * 24);
        const int grp = gh >> 3, dsh = grp * 2, dil = 1 << dsh, L = S_ >> dsh;
        const int pi0 = 64 * u, mm = pi0 / L, j0 = pi0 % L;
#pragma unroll
        for (int i = 0; i < 8; ++i) { const int r = (lane >> 3) + 8 * i;
            const v4u w = *(const v4u*)(VB + ((size_t)(b * 24 + gh) * S_ + pi0 + r) * 64 + c8 * 8);
            LAS unsigned* dst = (LAS unsigned*)(tile + r * 66 + c8 * 8); dst[0] = w.x; dst[1] = w.y; dst[2] = w.z; dst[3] = w.w; }
        asm volatile("s_waitcnt lgkmcnt(0)" ::: "memory");
#pragma unroll
        for (int i = 0; i < 8; ++i) { const int d = (lane >> 3) + 8 * i; const LAS unsigned short* s = tile + (8 * c8) * 66 + d;
            v4u o; o.x = (unsigned)s[0] | ((unsigned)s[66] << 16); o.y = (unsigned)s[2 * 66] | ((unsigned)s[3 * 66] << 16); o.z = (unsigned)s[4 * 66] | ((unsigned)s[5 * 66] << 16); o.w = (unsigned)s[6 * 66] | ((unsigned)s[7 * 66] << 16);
            *(v4u*)(VT + (((size_t)(b * 24 + gh) * 64 + (pi0 >> 5) + (c8 >> 2)) * 64 + d) * 32 + 8 * (c8 & 3)) = o; }
        asm volatile("s_waitcnt lgkmcnt(0)" ::: "memory");
    }
}

constexpr int LRU_CW = 132096;
constexpr int LRU_XR = 0, LRU_XR_SZ = 20992, LRU_XCB = 2 * LRU_XR_SZ, LRU_XCB_SZ = 24576, LRU_HST = LRU_XCB + 2 * LRU_XCB_SZ, LRU_HST_SZ = 20480;
static_assert(LRU_HST + 2 * LRU_HST_SZ <= LRU_CW && LRU_CW + 3200 <= MISC_OFF, "lru lds");
struct LruUnit { const bf16* wrp; const bf16* wip; float ba, bx, kk, hc; };
DI void lru_unit_setup(LruUnit& U, KP A, int nb, int dir, int cb, int lane) {
    const bf16* WG = (const bf16*)(kws(A) + WS_WG);
    const int n = 16 * cb + (lane & 15), kq = lane >> 4;
    U.wrp = WG + ((size_t)((nb * 2 + dir) * 2 + 0) * 80 + n) * 96 + 8 * kq;
    U.wip = WG + ((size_t)((nb * 2 + dir) * 2 + 1) * 80 + n) * 96 + 8 * kq;
    const int ch = dir * 1280 + 80 * nb + n;
    U.ba = kin(A, I_LBA)[ch] * 1.4426950408889634f; U.bx = kin(A, I_LBX)[ch] * 1.4426950408889634f;
    const float lam = kin(A, I_LAM)[ch]; const float nl = -lam; const float sp = fmaxf(nl, 0.f) + log1pf(__expf(-fabsf(nl)));
    U.kk = -8.0f * sp * 1.4426950408889634f; U.hc = 0.f;
}
DI void lru_unit_run(LruUnit& U, const bf16x8 (&wr)[3], const bf16x8 (&wi)[3], LAS unsigned char* xcb, LAS unsigned char* hst, int cb, int lane) {
    const int c = lane & 15, q = lane >> 4;
    float hc = U.hc;
#pragma unroll 1
    for (int half = 0; half < 2; ++half) {
        float av[4][4], bv[4][4], Ac[4], Bc[4];
#pragma unroll
        for (int t = 0; t < 4; ++t) {
            const int tb = 4 * half + t;
            f32x4 ar = {0.f, 0.f, 0.f, 0.f}, ai = {0.f, 0.f, 0.f, 0.f};
#pragma unroll
            for (int ks = 0; ks < 3; ++ks) {
                const bf16x8 a = *(const LAS bf16x8*)(xcb + (16 * tb + c) * 192 + (32 * ks + 8 * q) * 2);
                ar = __builtin_amdgcn_mfma_f32_16x16x32_bf16(a, wr[ks], ar, 0, 0, 0);
                ai = __builtin_amdgcn_mfma_f32_16x16x32_bf16(a, wi[ks], ai, 0, 0, 0);
            }
#pragma unroll
            for (int e = 0; e < 4; ++e) {
                const int s = 16 * tb + 4 * q + e;
                const float xc = bf1(*(const LAS unsigned short*)(xcb + s * 192 + (16 * cb + c) * 2));
                const float r = frcp(1.0f + __builtin_amdgcn_exp2f(-(ar[e] + U.ba))), ig = frcp(1.0f + __builtin_amdgcn_exp2f(-(ai[e] + U.bx)));
                const float a = __builtin_amdgcn_exp2f(U.kk * r);
                av[t][e] = a; bv[t][e] = __builtin_amdgcn_sqrtf(fmaxf(1.0f - a * a, 0.f)) * ig * xc;
            }
            Ac[t] = av[t][0] * av[t][1] * av[t][2] * av[t][3];
            Bc[t] = ((bv[t][0] * av[t][1] + bv[t][1]) * av[t][2] + bv[t][2]) * av[t][3] + bv[t][3];
        }
#pragma unroll
        for (int t = 0; t < 4; ++t) { const float A1 = __shfl_up(Ac[t], 16), B1 = __shfl_up(Bc[t], 16); if (q >= 1) { Bc[t] = Ac[t] * B1 + Bc[t]; Ac[t] = A1 * Ac[t]; } }
#pragma unroll
        for (int t = 0; t < 4; ++t) { const float A2 = __shfl_up(Ac[t], 32), B2 = __shfl_up(Bc[t], 32); if (q >= 2) { Bc[t] = Ac[t] * B2 + Bc[t]; Ac[t] = A2 * Ac[t]; } }
        float At[4], Bt[4], Ae[4], Be[4];
#pragma unroll
        for (int t = 0; t < 4; ++t) { At[t] = __shfl(Ac[t], 48 + c); Bt[t] = __shfl(Bc[t], 48 + c); Ae[t] = __shfl_up(Ac[t], 16); Be[t] = __shfl_up(Bc[t], 16); }
#pragma unroll
        for (int t = 0; t < 4; ++t) {
            const int tb = 4 * half + t;
            float h = (q == 0) ? hc : (Ae[t] * hc + Be[t]);
#pragma unroll
            for (int e = 0; e < 4; ++e) { h = av[t][e] * h + bv[t][e]; *(LAS unsigned short*)(hst + (16 * tb + 4 * q + e) * 160 + (16 * cb + c) * 2) = (unsigned short)pk2(h, 0.f); }
            hc = At[t] * hc + Bt[t];
        }
    }
    U.hc = hc;
}
#define LBAR() do { asm volatile("s_waitcnt lgkmcnt(0)" ::: "memory"); __builtin_amdgcn_s_barrier(); asm volatile("" ::: "memory"); } while (0)
DI void lru_item(KP A, const bf16* XL, const bf16* GL, bf16* HG, int b, int nb, LAS unsigned char* lds, int tid, int wave, int lane) {
    const int dir = wave >> 2, dtid = tid & 255;
    LAS unsigned char* xr = lds + LRU_XR + dir * LRU_XR_SZ;
    LAS unsigned char* xcb = lds + LRU_XCB + dir * LRU_XCB_SZ;
    LAS unsigned char* hst = lds + LRU_HST + dir * LRU_HST_SZ;
    const size_t rowbase = (size_t)b * S_;
    LruUnit U0, U1;
    const int u0 = wave, u1 = wave + 8; const bool two = wave < 2;
    lru_unit_setup(U0, A, nb, u0 / 5, u0 % 5, lane);
    lru_unit_setup(U1, A, nb, two ? u1 / 5 : 0, two ? u1 % 5 : 0, lane);
    { const int r = dtid >> 1, hf = dtid & 1; LAS v4u* z = (LAS v4u*)(xcb + r * 192 + 160 + hf * 16); *z = (v4u){0u, 0u, 0u, 0u}; }
    LAS float* cw = (LAS float*)(lds + LRU_CW + dir * 1600);
    for (int i = dtid; i < 400; i += 256) { const int j = i / 80, cc = i % 80; cw[i] = (j < 4) ? kin(A, I_LCW)[j * 1280 + 80 * nb + cc] : kin(A, I_LCB)[80 * nb + cc]; }
    {
        const int t0 = dir ? 15 * 128 : 0;
#pragma unroll
        for (int i = 0; i < 6; ++i) { const int idx = dtid + 256 * i; if (idx < 1310) { const int row = idx / 10, c8 = idx % 10; const int t = t0 - 2 + row;
            v4u w = (v4u){0u, 0u, 0u, 0u}; if (t >= 0 && t < S_) w = *(const v4u*)(XL + ((size_t)(b * 16 + nb) * S_ + t) * 80 + 8 * c8);
            *(LAS v4u*)(xr + row * 160 + c8 * 16) = w; } }
    }
    __syncthreads();
    bf16x8 w0r[3], w0i[3], w1r[3], w1i[3];
#pragma unroll
    for (int ks = 0; ks < 3; ++ks) { w0r[ks] = *(const bf16x8*)(U0.wrp + 32 * ks); w0i[ks] = *(const bf16x8*)(U0.wip + 32 * ks); w1r[ks] = *(const bf16x8*)(U1.wrp + 32 * ks); w1i[ks] = *(const bf16x8*)(U1.wip + 32 * ks); }
#pragma unroll 1
    for (int it = 0; it < 16; ++it) {
        const int ti = dir ? 15 - it : it, t0 = ti * 128;
        const bool second = it >= 8;
        v4u nx[6];
        {
            const int tn = (dir ? ti - 1 : ti + 1) * 128; const int dt = launder_v(dtid);
#pragma unroll
            for (int i = 0; i < 6; ++i) { const int idx = dt + 256 * i; const int row = idx / 10, c8 = idx % 10; const int t = tn - 2 + row;
                nx[i] = (v4u){0u, 0u, 0u, 0u}; if (it < 15 && idx < 1310 && t >= 0 && t < S_) nx[i] = *(const v4u*)(XL + ((size_t)(b * 16 + nb) * S_ + t) * 80 + 8 * c8); }
        }
        if (dtid < 250) {
            const int dt = launder_v(dtid); const int c8 = dt % 10, trow = dt / 10; const int ch = 80 * nb + 8 * c8;
            float w[4][8], bb[8];
#pragma unroll
            for (int j = 0; j < 4; ++j) { const f32x4 a0 = *(const LAS f32x4*)(cw + j * 80 + 8 * c8), a1 = *(const LAS f32x4*)(cw + j * 80 + 8 * c8 + 4);
                w[j][0] = a0.x; w[j][1] = a0.y; w[j][2] = a0.z; w[j][3] = a0.w; w[j][4] = a1.x; w[j][5] = a1.y; w[j][6] = a1.z; w[j][7] = a1.w; }
            { const f32x4 a0 = *(const LAS f32x4*)(cw + 320 + 8 * c8), a1 = *(const LAS f32x4*)(cw + 320 + 8 * c8 + 4);
                bb[0] = a0.x; bb[1] = a0.y; bb[2] = a0.z; bb[3] = a0.w; bb[4] = a1.x; bb[5] = a1.y; bb[6] = a1.z; bb[7] = a1.w; }
#pragma unroll 1
            for (int o = trow; o < 128; o += 25) {
                float acc[8];
#pragma unroll
                for (int e = 0; e < 8; ++e) acc[e] = bb[e];
#pragma unroll
                for (int j = 0; j < 4; ++j) { const v4u xw = *(const LAS v4u*)(xr + (o + j) * 160 + c8 * 16);
                    acc[0] += w[j][0] * bflo(xw.x); acc[1] += w[j][1] * bfhi(xw.x); acc[2] += w[j][2] * bflo(xw.y); acc[3] += w[j][3] * bfhi(xw.y);
                    acc[4] += w[j][4] * bflo(xw.z); acc[5] += w[j][5] * bfhi(xw.z); acc[6] += w[j][6] * bflo(xw.w); acc[7] += w[j][7] * bfhi(xw.w); }
                const int s = dir ? 127 - o : o;
                v4u ow; ow.x = pk2(acc[0], acc[1]); ow.y = pk2(acc[2], acc[3]); ow.z = pk2(acc[4], acc[5]); ow.w = pk2(acc[6], acc[7]);
                *(LAS v4u*)(xcb + s * 192 + c8 * 16) = ow;
            }
        }
        LBAR();
        v4u gt[5], pt[5];
        { const int dt = launder_v(dtid);
#pragma unroll
        for (int i = 0; i < 5; ++i) { const int idx = dt + 256 * i; const int srow = idx / 10, c8 = idx % 10; const int t = t0 + (dir ? 127 - srow : srow);
            gt[i] = (v4u){0u, 0u, 0u, 0u}; pt[i] = (v4u){0u, 0u, 0u, 0u};
            if (second) { gt[i] = *(const v4u*)(GL + ((size_t)(b * 16 + nb) * S_ + t) * 80 + 8 * c8); pt[i] = *(const v4u*)(HG + (rowbase + t) * 1280 + 80 * nb + 8 * c8); } } }
        lru_unit_run(U0, w0r, w0i, lds + LRU_XCB + (u0 / 5) * LRU_XCB_SZ, lds + LRU_HST + (u0 / 5) * LRU_HST_SZ, u0 % 5, lane);
        if (two) lru_unit_run(U1, w1r, w1i, lds + LRU_XCB + (u1 / 5) * LRU_XCB_SZ, lds + LRU_HST + (u1 / 5) * LRU_HST_SZ, u1 % 5, lane);
        LBAR();
        const int dt2 = launder_v(dtid);
#pragma unroll
        for (int i = 0; i < 5; ++i) { const int idx = dt2 + 256 * i; const int srow = idx / 10, c8 = idx % 10; const int t = t0 + (dir ? 127 - srow : srow);
            v4u hw = *(const LAS v4u*)(hst + srow * 160 + c8 * 16);
            if (second) {
                v4u o;
                o.x = pk2((bflo(hw.x) + bflo(pt[i].x)) * bflo(gt[i].x), (bfhi(hw.x) + bfhi(pt[i].x)) * bfhi(gt[i].x));
                o.y = pk2((bflo(hw.y) + bflo(pt[i].y)) * bflo(gt[i].y), (bfhi(hw.y) + bfhi(pt[i].y)) * bfhi(gt[i].y));
                o.z = pk2((bflo(hw.z) + bflo(pt[i].z)) * bflo(gt[i].z), (bfhi(hw.z) + bfhi(pt[i].z)) * bfhi(gt[i].z));
                o.w = pk2((bflo(hw.w) + bflo(pt[i].w)) * bflo(gt[i].w), (bfhi(hw.w) + bfhi(pt[i].w)) * bfhi(gt[i].w));
                hw = o;
            }
            *(v4u*)(HG + (rowbase + t) * 1280 + 80 * nb + 8 * c8) = hw; }
        const int dt3 = launder_v(dtid);
#pragma unroll
        for (int i = 0; i < 6; ++i) { const int idx = dt3 + 256 * i; if (idx < 1310) { const int row = idx / 10, c8 = idx % 10; *(LAS v4u*)(xr + row * 160 + c8 * 16) = nx[i]; } }
        if (it == 7) __syncthreads(); else LBAR();
    }
}

DI int crow(int r, int hi) { return (r & 3) + 8 * (r >> 2) + 4 * hi; }
DI int swap23(int i) { return (i & ~12) | ((i & 4) << 1) | ((i & 8) >> 1); }
DI int colx(int x) { return x ^ ((x >> 5) & 15); }
template <int NT> DI void attn_run(const bf16* QB, const bf16* KB, const bf16* VT, size_t rowbase, int b, int gh, int dil, int L, int mm, int jbase, float Mc, int jl, int hi, f32x16 (&o)[NT][2], float (&lsum)[NT]) {
    bf16x8 qf[NT][4];
#pragma unroll
    for (int t = 0; t < NT; ++t) { const bf16* qrow = QB + ((size_t)(b * 24 + gh) * S_ + mm * L + jbase + 32 * t + jl) * 64;
#pragma unroll
        for (int ks = 0; ks < 4; ++ks) qf[t][ks] = *(const bf16x8*)(qrow + 16 * ks + 8 * hi);
#pragma unroll
        for (int r = 0; r < 16; ++r) { o[t][0][r] = 0.f; o[t][1][r] = 0.f; }
        lsum[t] = 0.f; }
    const int jb = jbase >> 5;
    const int kb_lo = max(jb - 2, 0), kb_hi = min(jb + NT + 1, (L >> 5) - 1);
    const bf16* vrow0 = VT + ((size_t)(b * 24 + gh) * 64 + ((mm * L) >> 5)) * 2048 + jl * 32;
#pragma unroll 1
    for (int kb = kb_lo; kb <= kb_hi; ++kb) {
        bf16x8 kf[4], vf[2][2];
        { const int kj_ = 32 * kb + swap23(jl); const bf16* krow_ = KB + ((size_t)(b * 24 + gh) * S_ + mm * L + kj_) * 64;
#pragma unroll
          for (int ks = 0; ks < 4; ++ks) kf[ks] = *(const bf16x8*)(krow_ + 16 * ks + 8 * hi); }
#pragma unroll
        for (int mb = 0; mb < 2; ++mb)
#pragma unroll
            for (int ks = 0; ks < 2; ++ks) vf[mb][ks] = *(const bf16x8*)(vrow0 + (size_t)kb * 2048 + 1024 * mb + 16 * ks + 8 * hi);
#pragma unroll
        for (int t = 0; t < NT; ++t) {
            if (kb >= jb + t - 2 && kb <= jb + t + 2) {
                const int qj = jbase + 32 * t + jl;
                f32x16 s;
#pragma unroll
                for (int r = 0; r < 16; ++r) s[r] = 0.f;
#pragma unroll
                for (int ks = 0; ks < 4; ++ks) s = __builtin_amdgcn_mfma_f32_32x32x16_bf16(kf[ks], qf[t][ks], s, 0, 0, 0);
                float p[16];
#pragma unroll
                for (int r = 0; r < 16; ++r) { const int key = 32 * kb + swap23(crow(r, hi)); const int dj = key - qj;
                    const float pv = __builtin_amdgcn_exp2f(s[r] - Mc); p[r] = (dj <= 64 && dj >= -64) ? pv : 0.f; lsum[t] += p[r]; }
#pragma unroll
                for (int ks = 0; ks < 2; ++ks) {
                    v4u pw; pw.x = pk2(p[8 * ks + 0], p[8 * ks + 1]); pw.y = pk2(p[8 * ks + 2], p[8 * ks + 3]); pw.z = pk2(p[8 * ks + 4], p[8 * ks + 5]); pw.w = pk2(p[8 * ks + 6], p[8 * ks + 7]);
                    const bf16x8 pf = __builtin_bit_cast(bf16x8, pw);
                    o[t][0] = __builtin_amdgcn_mfma_f32_32x32x16_bf16(vf[0][ks], pf, o[t][0], 0, 0, 0);
                    o[t][1] = __builtin_amdgcn_mfma_f32_32x32x16_bf16(vf[1][ks], pf, o[t][1], 0, 0, 0);
                }
            }
        }
    }
}
DI void attn_merge(LAS float* Ot, LAS float* Ls, bool first, int x, int hi, const f32x16& o0, const f32x16& o1, float lsum) {
    lsum += __shfl_xor(lsum, 32);
    const int cx = colx(x);
    if (first) {
#pragma unroll
        for (int r = 0; r < 16; ++r) { Ot[crow(r, hi) * 512 + cx] = o0[r]; Ot[(32 + crow(r, hi)) * 512 + cx] = o1[r]; }
        if (hi == 0) Ls[x] = lsum;
    } else {
#pragma unroll
        for (int r = 0; r < 16; ++r) { Ot[crow(r, hi) * 512 + cx] += o0[r]; Ot[(32 + crow(r, hi)) * 512 + cx] += o1[r]; }
        if (hi == 0) Ls[x] += lsum;
    }
}
DI void attn_unit(KP A, const bf16* QB, const bf16* KB, const bf16* VT, bf16* OA, int b, int h, int pb, LAS unsigned char* lds, int tid, int wave, int lane) {
    LAS float* Ot = (LAS float*)lds;
    LAS float* Ls = (LAS float*)(lds + 131072);
    const size_t rowbase = (size_t)b * S_;
    const int P = 512 * pb;
#pragma unroll 1
    for (int g = 0; g < 3; ++g) {
        const int ln_ = launder_v(lane); const int jl = ln_ & 31, hi = ln_ >> 5;
        const int dsh = 2 * g, dil = 1 << dsh, L = S_ >> dsh;
        const int gh = g * 8 + h;
        float mq = fabsf(kin(A, I_QNG)[g * 64 + ln_]), mk = fabsf(kin(A, I_KNG)[g * 64 + ln_]);
        mq = wave_max(mq); mk = wave_max(mk);
        const float Mc = 8.0f * mq * mk * 1.4426950408889634f;
        if (g < 2) {
            int mm, jbase, xa, xb;
            if (g == 0) { mm = 0; jbase = P + 64 * wave; xa = 64 * wave + jl; xb = xa + 32; }
            else { mm = wave & 3; const int jp = wave >> 2; jbase = (P >> 2) + 64 * jp; xa = 4 * (64 * jp + jl) + mm; xb = xa + 128; }
            f32x16 o[2][2]; float ls[2];
            attn_run<2>(QB, KB, VT, rowbase, b, gh, dil, L, mm, jbase, Mc, jl, hi, o, ls);
            attn_merge(Ot, Ls, g == 0, xa, hi, o[0][0], o[0][1], ls[0]);
            attn_merge(Ot, Ls, g == 0, xb, hi, o[1][0], o[1][1], ls[1]);
        } else {
#pragma unroll 1
            for (int sl = 0; sl < 2; ++sl) {
                const int mm = 2 * wave + sl, jbase = P >> 4, x = 16 * jl + mm;
                f32x16 o[1][2]; float ls[1];
                attn_run<1>(QB, KB, VT, rowbase, b, gh, dil, L, mm, jbase, Mc, jl, hi, o, ls);
                attn_merge(Ot, Ls, false, x, hi, o[0][0], o[0][1], ls[0]);
            }
        }
        __syncthreads();
    }
    {
        const int x = launder_v(tid), cx = colx(x);
        const float inv = 1.0f / Ls[x];
        bf16* orow = OA + (rowbase + P + x) * 512 + h * 64;
#pragma unroll
        for (int c = 0; c < 8; ++c) { float v[8];
#pragma unroll
            for (int e = 0; e < 8; ++e) v[e] = Ot[(8 * c + e) * 512 + cx] * inv;
            v4u w; w.x = pk2(v[0], v[1]); w.y = pk2(v[2], v[3]); w.z = pk2(v[4], v[5]); w.w = pk2(v[6], v[7]);
            *(v4u*)(orow + 8 * c) = w; }
    }
    __syncthreads();
}

DI void p4b_ffn_act(KP A, const bf16* UP, bf16* H, int Tc, int tid, int G) {
    const int gt = blockIdx.x * (NWAVES * 64) + tid, NGT = G * NWAVES * 64;
    const int nitems = (Tc / 8) * 384;
    for (int it = gt; it < nitems; it += NGT) {
        const int cc = it % 384, tg = it / 384; const int ch = 8 * cc; const int t0 = 8 * tg; const int pos0 = t0 & (S_ - 1);
        float w0[8], w1[8], w2[8], bb[8];
        { const float* p = kin(A, I_FCW) + ch; const f32x4 a0 = *(const f32x4*)p, a1 = *(const f32x4*)(p + 4), b0 = *(const f32x4*)(p + DFF), b1 = *(const f32x4*)(p + DFF + 4), c0 = *(const f32x4*)(p + 2 * DFF), c1 = *(const f32x4*)(p + 2 * DFF + 4);
          const f32x4 d0 = *(const f32x4*)(kin(A, I_FCB) + ch), d1 = *(const f32x4*)(kin(A, I_FCB) + ch + 4);
#pragma unroll
          for (int e = 0; e < 4; ++e) { w0[e] = a0[e]; w0[e + 4] = a1[e]; w1[e] = b0[e]; w1[e + 4] = b1[e]; w2[e] = c0[e]; w2[e + 4] = c1[e]; bb[e] = d0[e]; bb[e + 4] = d1[e]; } }
        const bf16* gp = UP + (size_t)t0 * 6144 + ch;
        float gm[8], gc[8], gn[8];
        { v4u w = (v4u){0u, 0u, 0u, 0u}; if (pos0 != 0) w = *(const v4u*)(gp - 6144);
          gm[0] = bflo(w.x); gm[1] = bfhi(w.x); gm[2] = bflo(w.y); gm[3] = bfhi(w.y); gm[4] = bflo(w.z); gm[5] = bfhi(w.z); gm[6] = bflo(w.w); gm[7] = bfhi(w.w); }
        { const v4u w = *(const v4u*)gp;
          gc[0] = bflo(w.x); gc[1] = bfhi(w.x); gc[2] = bflo(w.y); gc[3] = bfhi(w.y); gc[4] = bflo(w.z); gc[5] = bfhi(w.z); gc[6] = bflo(w.w); gc[7] = bfhi(w.w); }
#pragma unroll
        for (int i = 0; i < 8; ++i) {
            v4u w = (v4u){0u, 0u, 0u, 0u}; if (i < 7 || pos0 + 8 < S_) w = *(const v4u*)(gp + (size_t)(i + 1) * 6144);
            gn[0] = bflo(w.x); gn[1] = bfhi(w.x); gn[2] = bflo(w.y); gn[3] = bfhi(w.y); gn[4] = bflo(w.z); gn[5] = bfhi(w.z); gn[6] = bflo(w.w); gn[7] = bfhi(w.w);
            const v4u vw = *(const v4u*)(gp + (size_t)i * 6144 + DFF);
            const float vv[8] = {bflo(vw.x), bfhi(vw.x), bflo(vw.y), bfhi(vw.y), bflo(vw.z), bfhi(vw.z), bflo(vw.w), bfhi(vw.w)};
            float o[8];
#pragma unroll
            for (int e = 0; e < 8; ++e) { const float pre = bb[e] + w0[e] * gm[e] + w1[e] * gc[e] + w2[e] * gn[e]; o[e] = gelu_t(pre) * vv[e]; gm[e] = gc[e]; gc[e] = gn[e]; }
            v4u ow; ow.x = pk2(o[0], o[1]); ow.y = pk2(o[2], o[3]); ow.z = pk2(o[4], o[5]); ow.w = pk2(o[6], o[7]);
            *(v4u*)(H + (size_t)(t0 + i) * DFF + ch) = ow;
        }
    }
}

DI void p4c_fixup(KP A, const float* SB, bf16* H, int Tc, int tid, int G) {
    const int gt = blockIdx.x * (NWAVES * 64) + tid, NGT = G * NWAVES * 64;
    const int nedge = (Tc / 256) * 8, nitems = nedge * 768;
    for (int it = gt; it < nitems; it += NGT) {
        const int c4 = it % 768, e = it / 768; const int ch = 4 * c4;
        const int last = e & 1, run = (e >> 1) & 3, tile = e >> 3; const int row = tile * 256 + run * 64 + (last ? 63 : 0); const int pos = row & (S_ - 1);
        const float* sb = SB + (size_t)e * 9216 + ch;
        f32x4 pre = *(const f32x4*)(sb + 3072); const f32x4 v = *(const f32x4*)(sb + 6144);
        if (!last && pos != 0) { const f32x4 gnb = *(const f32x4*)(sb - 9216); const f32x4 w0 = *(const f32x4*)(kin(A, I_FCW) + ch); pre = pre + w0 * gnb; }
        if (last && pos != S_ - 1) { const f32x4 gnb = *(const f32x4*)(sb + 9216); const f32x4 w2 = *(const f32x4*)(kin(A, I_FCW) + 2 * DFF + ch); pre = pre + w2 * gnb; }
        v2u w; w.x = pk2(gelu_t(pre[0]) * v[0], gelu_t(pre[1]) * v[1]); w.y = pk2(gelu_t(pre[2]) * v[2], gelu_t(pre[3]) * v[3]);
        *(v2u*)(H + (size_t)row * DFF + ch) = w;
    }
}

#define XB_TMO      128
#define XB_XCNT(j)  (256  + 64 * (j))
#define XB_XSUB(j)  (1280 + 64 * (j))
#define XB_XGEN(j)  (2304 + 64 * (j))
#define XB_TOP      3328
#define XB_TOPGEN   3392
#define XCD_BAR_WORDS 3456
#define XB_SPIN_CAP (1u << 18)

__device__ __forceinline__ unsigned xb_ld(unsigned* p)              { return __hip_atomic_load(p, __ATOMIC_RELAXED, __HIP_MEMORY_SCOPE_AGENT); }
__device__ __forceinline__ unsigned xb_add(unsigned* p, unsigned v) { return __hip_atomic_fetch_add(p, v, __ATOMIC_RELAXED, __HIP_MEMORY_SCOPE_AGENT); }
__device__ __forceinline__ unsigned xb_xcc_id() { return (unsigned)__builtin_amdgcn_s_getreg((3 << 11) | 20) & 0xFu; }
#define XB_SPIN(cond, bar) do { unsigned _sp = 0; while (cond) { __builtin_amdgcn_s_sleep(1); \
    if ((++_sp & 255u) == 0u) { if (xb_ld(&(bar)[XB_TMO])) break; if (_sp > XB_SPIN_CAP) { atomicAdd(&(bar)[XB_TMO], 1u); break; } } } } while (0)

struct XcdBarrier {
    unsigned* bar; unsigned x;
    volatile LAS unsigned* st;
};

__device__ __forceinline__ XcdBarrier xcd_barrier_post(unsigned* bar, volatile LAS unsigned* st) {
    XcdBarrier b; b.bar = bar; b.x = xb_xcc_id(); b.st = st;
    if (threadIdx.x == 0) (void)xb_add(&bar[XB_XCNT(b.x)], 1u);
    return b;
}
__device__ __forceinline__ void xcd_barrier_complete(unsigned* bar, unsigned x, unsigned& nloc, unsigned& nx) {
    const unsigned G = gridDim.x * gridDim.y * gridDim.z;
    unsigned sum, cnt, mine, sp = 0u;
    for (;;) {
        sum = 0u; cnt = 0u; mine = 0u;
#pragma unroll
        for (unsigned j = 0; j < 16; ++j) { const unsigned c = xb_ld(&bar[XB_XCNT(j)]); sum += c; cnt += (c > 0u) ? 1u : 0u; mine = (j == x) ? c : mine; }
        if (sum == G) break;
        __builtin_amdgcn_s_sleep(1);
        if ((++sp & 255u) == 0u) { if (xb_ld(&bar[XB_TMO])) break; if (sp > XB_SPIN_CAP) { atomicAdd(&bar[XB_TMO], 1u); break; } }
    }
    nloc = mine > 0u ? mine : 1u; nx = cnt > 0u ? cnt : 1u;
}

__device__ __forceinline__ void xcd_barrier(const XcdBarrier& b) {
    asm volatile("s_waitcnt vmcnt(0)" ::: "memory");
    __syncthreads();
    if (threadIdx.x == 0) {
        unsigned* bar = b.bar;
        __builtin_amdgcn_s_waitcnt(0);
        unsigned nloc = b.st[0], nx = b.st[1];
        if (nloc == 0u) { xcd_barrier_complete(bar, b.x, nloc, nx); b.st[0] = nloc; b.st[1] = nx; }
        const unsigned old = xb_add(&bar[XB_XSUB(b.x)], 1u);
        const unsigned gen = old / nloc;
        if (old + 1u == (gen + 1u) * nloc) {
            __builtin_amdgcn_fence(__ATOMIC_RELEASE, "agent");
            asm volatile("s_waitcnt vmcnt(0)" ::: "memory");
            const unsigned og = xb_add(&bar[XB_TOP], 1u);
            const unsigned tg = og / nx;
            if (og + 1u == (tg + 1u) * nx) xb_add(&bar[XB_TOPGEN], 1u);
            else XB_SPIN(xb_ld(&bar[XB_TOPGEN]) == tg, bar);
            __builtin_amdgcn_fence(__ATOMIC_ACQUIRE, "agent");
            xb_add(&bar[XB_XGEN(b.x)], 1u);
            asm volatile("s_waitcnt vmcnt(0)" ::: "memory");
        } else {
            XB_SPIN(xb_ld(&bar[XB_XGEN(b.x)]) == gen, bar);
            __builtin_amdgcn_fence(__ATOMIC_ACQUIRE, "agent");
            asm volatile("s_waitcnt vmcnt(0)" ::: "memory");
        }
    }
    __syncthreads();
}

constexpr size_t CTL_BAR = 512 * 1024;
DI void grid_bar_cg() { cg::this_grid().sync(); }
DI void grid_bar(LAS unsigned char* lds) {
    const KP k = kp_fresh();
    XcdBarrier b; b.bar = (unsigned*)(kws(k) + WS_CTL + CTL_BAR); b.x = xb_xcc_id(); b.st = (volatile LAS unsigned*)(lds + MISC_OFF + 32);
    xcd_barrier(b);
}
struct Ctx { int Tc, grow0, G; unsigned char* ws; bf16 *XN, *MG, *PROJ, *H, *HG, *OA, *XL, *GL, *QB, *KB, *VB, *GT; float* out; float* SS; };
DI Ctx make_ctx(KP k, int c) {
    Ctx X; const int Tm = kspc(k) * S_; X.Tc = kcnt(k, c) * S_; X.grow0 = kstart(k, c) * S_; X.G = gridDim.x; X.ws = kws(k); X.out = kout(k);
    X.SS = (float*)(X.ws + WS_CTL + CTL_SS);
    X.XN = (bf16*)(X.ws + WS_ACT); X.MG = (bf16*)(X.ws + WS_ACT + (size_t)Tm * 2048); X.PROJ = (bf16*)(X.ws + WS_ACT + (size_t)Tm * 4096);
    X.H = (bf16*)(X.ws + WS_ACT + (size_t)Tm * 4096 + (size_t)Tm * 8192);
    { unsigned char* rg = (unsigned char*)X.PROJ; X.XL = (bf16*)rg; X.GL = (bf16*)(rg + (size_t)Tm * 2560); X.QB = (bf16*)(rg + (size_t)Tm * 5120); X.KB = (bf16*)(rg + (size_t)Tm * 8192); X.VB = (bf16*)(rg + (size_t)Tm * 11264); X.GT = (bf16*)(rg + (size_t)Tm * 14336); }
    X.HG = (bf16*)(X.out + (size_t)X.grow0 * 1024); X.OA = (bf16*)((unsigned char*)X.HG + (size_t)X.Tc * 2560);
    return X;
}
#define PH_PRE(c) const int tid = launder_v(threadIdx.x), lane = tid & 63, wave = __builtin_amdgcn_readfirstlane(tid >> 6); (void)lane; (void)wave; const KP k = kp_fresh(); const Ctx X = make_ctx(k, launder_i(c));
DI void ph_p0(LAS unsigned char* lds) { PH_PRE(0) p0_weights(k, lds, tid, wave, lane, X.G); p0_xn(k, X.XN, X.grow0, X.Tc, wave, lane, X.G); }
DI void ph_p1(LAS unsigned char* lds, int c) { PH_PRE(c)
    pg8::Gemm g{(c == 0) ? X.XN : X.MG, (const bf16*)(X.ws + WS_WIN), X.Tc, INC, 1024}; pg8::StaticOrder S; S.init(X.Tc, INC, X.G, launder_i((int)blockIdx.x));
    pg8::EpiProj E{X.XL, X.GL, X.QB, X.KB, X.VB, X.GT, (const float*)(X.ws + WS_ROPE), kin(k, I_QNG), kin(k, I_KNG), QSCALE};
    pg8::gemm_phase<pg8::EpiProj, pg8::StaticOrder, true, true>(lds, g, S, E); }
DI void ph_p1b(LAS unsigned char* lds, int c) { PH_PRE(c) p1b_qknorm_vt(k, X.VB, X.XN, X.Tc, lds, wave, lane, X.G); }
constexpr size_t CTL_Q = 768 * 1024;
DI void ph_p2(LAS unsigned char* lds, int c, int cslot, int what) { PH_PRE(c)
    volatile LAS int* misc = (volatile LAS int*)(lds + MISC_OFF);
    unsigned* qh = (unsigned*)(X.ws + WS_CTL + CTL_Q) + 64 * 8 * cslot;
    const int spc = X.Tc / S_;
    const int n_lru8 = spc * 2, n_att8 = spc * 4, total8 = n_lru8 + n_att8;
    const int myx = (int)(xb_xcc_id() & 7u);
#pragma unroll 1
    for (int hop = 0; hop < 8; ++hop) {
        const int xq = (myx + hop) & 7;
        for (;;) {
            if (tid == 0) misc[0] = (int)atomicAdd(qh + 64 * xq, 1u);
            __syncthreads();
            const int q = misc[0];
            __syncthreads();
            if (q >= total8) break;
            if (q < n_lru8) { const int item = xq + 8 * q; if (what & 1) lru_item(k, X.XL, X.GL, X.HG, item / 16, item % 16, lds, tid, wave, lane); }
            else if (what & 2) { const int qa = q - n_lru8; const int bh = xq + 8 * (qa >> 2), pb = qa & 3; attn_unit(k, X.QB, X.KB, X.XN, X.OA, bh >> 3, bh & 7, pb, lds, tid, wave, lane); }
        }
    } }
DI void ph_p3a1(LAS unsigned char* lds, int c) { PH_PRE(c)
    pg8::Gemm g{X.HG, (const bf16*)(X.ws + WS_WLO), X.Tc, 1024, 1280}; pg8::StaticOrder S; S.init(X.Tc, 1024, X.G, launder_i((int)blockIdx.x));
    pg8::EpiMerge<false> E{X.MG, (const unsigned char*)X.GT, 2048};
    pg8::gemm_phase<pg8::EpiMerge<false>, pg8::StaticOrder, true, true>(lds, g, S, E); }
DI void ph_p3a2(LAS unsigned char* lds, int c) { PH_PRE(c)
    pg8::Gemm g{X.OA, (const bf16*)(X.ws + WS_WAO), X.Tc, 1024, 512}; pg8::StaticOrder S; S.init(X.Tc, 1024, X.G, launder_i((int)blockIdx.x));
    pg8::EpiMerge<true> E{X.MG, (const unsigned char*)X.GT + 1024, 2048};
    pg8::gemm_phase<pg8::EpiMerge<true>, pg8::StaticOrder, true, true>(lds, g, S, E); }
DI void ph_p3b(LAS unsigned char* lds, int c) { PH_PRE(c)
    pg8::Gemm g{X.MG, (const bf16*)(X.ws + WS_WO), X.Tc, 1024, 1024}; pg8::StaticOrder S; S.init(X.Tc, 1024, X.G, launder_i((int)blockIdx.x));
    pg8::EpiWo E{kin(k, I_XP), kin(k, I_XS), X.out, X.XN, X.SS, X.grow0};
    pg8::gemm_phase<pg8::EpiWo, pg8::StaticOrder, true, true>(lds, g, S, E); }
DI void ph_p4(LAS unsigned char* lds, int c) { PH_PRE(c)
    pg8::Gemm g{X.XN, (const bf16*)(X.ws + WS_WUP), X.Tc, 6144, 1024}; pg8::StaticOrder S; S.init(X.Tc, 6144, X.G, launder_i((int)blockIdx.x));
    pg8::EpiUpFused E{X.H, X.SS, X.grow0, kin(k, I_FCW), kin(k, I_FCB), (float*)X.PROJ};
    pg8::gemm_phase<pg8::EpiUpFused, pg8::StaticOrder, true, true>(lds, g, S, E); }
DI void ph_p4b(LAS unsigned char* lds, int c) { PH_PRE(c) p4c_fixup(k, (const float*)X.PROJ, X.H, X.Tc, tid, X.G); }
DI void ph_p5(LAS unsigned char* lds, int c) { PH_PRE(c)
    pg8::Gemm g{X.H, (const bf16*)(X.ws + WS_WDN), X.Tc, 1024, 3072}; pg8::StaticOrder S; S.init(X.Tc, 1024, X.G, launder_i((int)blockIdx.x));
    pg8::EpiDown E{X.out, X.XN, X.grow0};
    pg8::gemm_phase<pg8::EpiDown, pg8::StaticOrder, true, true>(lds, g, S, E); }
DI void ph_xn_next(LAS unsigned char* lds, int c) { PH_PRE(c) p0_xn(k, X.MG, kstart(k, c + 1) * S_, kcnt(k, c + 1) * S_, wave, lane, X.G); }

__global__ void __launch_bounds__(NWAVES * 64, 2) hybrid_fwd(Args args) {
    extern __shared__ __attribute__((aligned(16))) unsigned char lds_raw[];
    LAS unsigned char* lds = (LAS unsigned char*)lds_raw;
    const int nchunks = args.nch;
    { volatile LAS unsigned* st = (volatile LAS unsigned*)(lds + MISC_OFF); if (threadIdx.x < 64) st[threadIdx.x] = 0u; __syncthreads();
      (void)xcd_barrier_post((unsigned*)(args.ws + WS_CTL + CTL_BAR), (volatile LAS unsigned*)(lds + MISC_OFF + 32)); }
    if (PHM & 1) ph_p0(lds);
    if (REP & 1) { grid_bar_cg(); ph_p0(lds); }
    cg::this_grid().sync();
#pragma unroll 1
    for (int c = 0; c < nchunks; ++c) {
        if (PHM & 2) ph_p1(lds, c);
        grid_bar(lds);
        if (REP & 2) { ph_p1(lds, c); grid_bar(lds); }
        if (PHM & 4) ph_p1b(lds, c);
        grid_bar(lds);
        if (REP & 4) { ph_p1b(lds, c); grid_bar(lds); }
        ph_p2(lds, c, c, 3);
        grid_bar(lds);
        if (REP & 8) { ph_p2(lds, c, c + 8, 3); grid_bar(lds); }
        if (REP & 16) { ph_p2(lds, c, c + 16, 1); grid_bar(lds); }
        if (REP & 32768) { ph_p2(lds, c, c + 24, 2); grid_bar(lds); }
        if (PHM & 32) ph_p3a1(lds, c);
        if (PHM & 64) ph_p3a2(lds, c);
        grid_bar(lds);
        if (REP & 32) { ph_p3a1(lds, c); ph_p3a2(lds, c); grid_bar(lds); }
        if (PHM & 128) ph_p3b(lds, c);
        grid_bar(lds);
        if (PHM & 256) ph_p4(lds, c);
        grid_bar(lds);
        if (REP & 256) { ph_p4(lds, c); grid_bar(lds); }
        if (PHM & 512) ph_p4b(lds, c);
        grid_bar(lds);
        if (REP & 512) { ph_p4b(lds, c); grid_bar(lds); }
        if (PHM & 1024) ph_p5(lds, c);
        if (c + 1 < nchunks) { if (PHM & 1) ph_xn_next(lds, c); grid_bar(lds); }
    }
}

extern "C" void kernel_launch(void* const* d_in, const int* in_sizes, int n_in, void* d_out, int out_size, void* d_ws, size_t ws_size, hipStream_t stream) {
    static int grid = 0, spc = 0;
    if (grid == 0) {
        int dev = 0, cus = 0, per_cu = 0;
        if (hipGetDevice(&dev) != hipSuccess || hipDeviceGetAttribute(&cus, hipDeviceAttributeMultiprocessorCount, dev) != hipSuccess) { fprintf(stderr, "kernel_launch: device query failed\n"); grid = -1; return; }
        if (hipFuncSetAttribute((const void*)hybrid_fwd, hipFuncAttributeMaxDynamicSharedMemorySize, LDS_BYTES) != hipSuccess) { fprintf(stderr, "kernel_launch: hipFuncSetAttribute failed\n"); grid = -1; return; }
        if (hipOccupancyMaxActiveBlocksPerMultiprocessor(&per_cu, (const void*)hybrid_fwd, NWAVES * 64, LDS_BYTES) != hipSuccess || per_cu < 1) { fprintf(stderr, "kernel_launch: occupancy query gives %d\n", per_cu); per_cu = 1; }
        (void)hipGetLastError();
        grid = cus;
        const int cand[8] = {24, 16, 8, 5, 4, 2, 1, 0};
        for (int i = 0; cand[i]; ++i) if (WS_ACT + (size_t)cand[i] * S_ * ACT_PER_TOK <= ws_size) { spc = cand[i]; break; }
        if (spc == 0) { fprintf(stderr, "kernel_launch: workspace too small (%zu)\n", ws_size); grid = -1; return; }
        fprintf(stderr, "kernel_launch: grid %d, per_cu %d, spc %d, ws %zu\n", grid, per_cu, spc, ws_size);
    }
    if (grid < 0) return;
    (void)hipMemsetAsync((char*)d_ws + WS_CTL, 0, CTL_BYTES, stream);
    Args a{};
    for (int i = 0; i < 21; ++i) a.in[i] = (const float*)d_in[i];
    a.out = (float*)d_out; a.ws = (unsigned char*)d_ws; a.spc = spc;
    { int st = 0, n = 0; while (st < NSEQ && n < 6) { const int m = (NSEQ - st < spc) ? NSEQ - st : spc; a.start[n] = st; a.cnt[n] = m; st += m; ++n; } a.nch = n;
      if (st < NSEQ) { fprintf(stderr, "kernel_launch: too many chunks\n"); return; } }
    void* kargs[] = {&a};
    hipError_t e = hipLaunchCooperativeKernel((const void*)hybrid_fwd, dim3(grid), dim3(NWAVES * 64), kargs, LDS_BYTES, stream);
    if (e != hipSuccess) fprintf(stderr, "kernel_launch: cooperative launch failed: %s (grid %d)\n", hipGetErrorString(e), grid);
}
```

```cpp
#include <hip/hip_runtime.h>
#include <hip/hip_cooperative_groups.h>
#include <cstdio>
#include <cstdint>
namespace cg = cooperative_groups;
namespace pg8 {
#define PG8_LAS __attribute__((address_space(3)))
typedef unsigned short bf16_t;
typedef short bf16x8 __attribute__((ext_vector_type(8)));
typedef float f32x4 __attribute__((ext_vector_type(4)));
typedef unsigned u32x4 __attribute__((ext_vector_type(4)));
constexpr int BM = 256, BK = 64, HALF = 128, HTB = HALF * BK * 2  , STAGE_BYTES = 8 * HTB, NXCD = 8, WGM = 8;

__host__ __device__ __forceinline__ int lds_byte(int r, int c) { const int st = (r >> 4) * 2 + (c >> 5), rr = r & 15, cc = c & 31, ob = rr * 64 + cc * 2; return st * 1024 + (ob ^ (((ob >> 9) & 1) << 5)); }
__host__ __device__ __forceinline__ void stage_rc(int b, int& R, int& C) { const int st = b / 1024, sb = b % 1024, swz = sb ^ (((sb >> 9) & 1) << 5); R = (st >> 1) * 16 + swz / 64; C = (st & 1) * 32 + (swz % 64) / 2; }
__host__ __device__ __forceinline__ int perm32(int rho) { const int n = rho >> 4, i = rho & 15; return 8 * (i >> 2) + 4 * n + (i & 3); }

struct Unit { int pm, pn; };
struct Gemm { const bf16_t* A; const bf16_t* Bt; int M, N, K; };

struct StaticOrder {
    int nM, nN, nwg, G, c;
    __host__ __device__ void init(int M, int N, int G_, int c_) { nM = M / BM; nN = N / BM; nwg = nM * nN; G = G_; c = c_; }
    __host__ __device__ bool next(int i, Unit& u) const {
        const long L = (long)i * G + c; if (L >= nwg) return false;
        int wgid = (int)L; { const int q = nwg / NXCD, r = nwg % NXCD, xcd = wgid % NXCD, off = wgid / NXCD; wgid = (xcd < r ? xcd * (q + 1) : r * (q + 1) + (xcd - r) * q) + off; }
        const int nig = WGM * nN, gid = wgid / nig, fm = gid * WGM, gsz = (nM - fm) < WGM ? (nM - fm) : WGM;
        u.pm = fm + ((wgid % nig) % gsz); u.pn = (wgid % nig) / gsz; return true;
    }
    __device__ __forceinline__ void a_ready(const Unit&) const {}
    __device__ __forceinline__ void done(const Unit&) const {}
};

__device__ __forceinline__ unsigned cvt_pk_bf16(float lo, float hi) { unsigned r; asm volatile("v_cvt_pk_bf16_f32 %0, %1, %2" : "=v"(r) : "v"(lo), "v"(hi)); return r; }
typedef float f32x2 __attribute__((ext_vector_type(2)));
typedef unsigned u32x2 __attribute__((ext_vector_type(2)));
__device__ __forceinline__ float fast_rcp(float x) { return __builtin_amdgcn_rcpf(x); }
__device__ __forceinline__ float sigmoid_f(float x) { return fast_rcp(1.0f + __expf(-x)); }
__device__ __forceinline__ float gelu_tanh_f(float x) { const float u = 0.7978845608028654f * (x + 0.044715f * x * x * x); return x * fast_rcp(1.0f + __expf(-2.0f * u)); }
__device__ __forceinline__ float bf_lo(unsigned w) { return __uint_as_float(w << 16); }
__device__ __forceinline__ float bf_hi(unsigned w) { return __uint_as_float(w & 0xffff0000u); }

struct EpiProj {
    static constexpr bool PERM = true, AFTER_DRAIN = false;
    bf16_t *XL, *GL, *QB, *KB, *VB, *GT; const float* RT; const float* qg; const float* kg; float qscale;
    __device__ __forceinline__ static int permpos(int t, int g) { const int dsh = 2 * g; return (t & ((1 << dsh) - 1)) * (2048 >> dsh) + (t >> dsh); }
    __device__ __forceinline__ void operator()(const f32x4 (&acc)[2][2][4][2], const Unit& u, int wr, int wc, int fr, int fq) const {
        const int colt = u.pn * BM;
        const int row0 = u.pm * BM + wr * 64 + fr;
        if (colt >= 2560 && colt < 5632) {
            const bool isk = colt >= 4096; const int cb0 = colt - (isk ? 4096 : 2560); const int grp = cb0 >> 9; const int gh = (cb0 >> 6) + wc;
            const float* gp = (isk ? kg : qg) + grp * 64 + 8 * fq;
            f32x4 gn[2][2];
#pragma unroll
            for (int bj = 0; bj < 2; ++bj)
#pragma unroll
                for (int n = 0; n < 2; ++n) gn[bj][n] = *(const f32x4*)(gp + 32 * bj + 4 * n);
            const float sc = isk ? 1.0f : qscale;
            bf16_t* OB = isk ? KB : QB;
#pragma unroll
            for (int ai = 0; ai < 2; ++ai)
#pragma unroll
                for (int m = 0; m < 4; ++m) { const int lrow = row0 + ai * HALF + m * 16; const int pos = lrow & 2047, bb = lrow >> 11;
                    f32x4 y[2][2]; float ss = 0.f;
#pragma unroll
                    for (int bj = 0; bj < 2; ++bj)
#pragma unroll
                        for (int n = 0; n < 2; ++n) { y[bj][n] = acc[ai][bj][m][n]; ss += (y[bj][n][0] * y[bj][n][0] + y[bj][n][1] * y[bj][n][1]) + (y[bj][n][2] * y[bj][n][2] + y[bj][n][3] * y[bj][n][3]); }
                    ss += __shfl_xor(ss, 16); ss += __shfl_xor(ss, 32);
                    const float rs = __builtin_amdgcn_rsqf(ss * (1.0f / 64.0f) + 1e-6f);
#pragma unroll
                    for (int bj = 0; bj < 2; ++bj)
#pragma unroll
                        for (int n = 0; n < 2; ++n) y[bj][n] = y[bj][n] * gn[bj][n] * rs;
#pragma unroll
                    for (int n = 0; n < 2; ++n) { f32x4 pr;
#pragma unroll
                        for (int e = 0; e < 4; ++e) pr[e] = __shfl_xor(y[0][n][e], 16);
                        if (fq < 2) { const f32x4 t0 = *(const f32x4*)(RT + (size_t)pos * 16 + 8 * n), t1 = *(const f32x4*)(RT + (size_t)pos * 16 + 8 * n + 4);
                            const float co[4] = {t0[0], t0[2], t1[0], t1[2]}, si[4] = {t0[1], t0[3], t1[1], t1[3]};
#pragma unroll
                            for (int e = 0; e < 4; ++e) y[0][n][e] = (fq == 0) ? (y[0][n][e] * co[e] - pr[e] * si[e]) : (y[0][n][e] * co[e] + pr[e] * si[e]); } }
                    bf16_t* rowp = OB + ((size_t)(bb * 24 + gh) * 2048 + permpos(pos, grp)) * 64 + 8 * fq;
#pragma unroll
                    for (int bj = 0; bj < 2; ++bj) { const f32x4 v0 = y[bj][0] * sc, v1 = y[bj][1] * sc;
                        u32x4 w; w.x = cvt_pk_bf16(v0[0], v0[1]); w.y = cvt_pk_bf16(v0[2], v0[3]); w.z = cvt_pk_bf16(v1[0], v1[1]); w.w = cvt_pk_bf16(v1[2], v1[3]);
                        *(u32x4*)(rowp + 32 * bj) = w; }
                    asm volatile("" ::: "memory"); }
            return;
        }
        const int mode = (colt >= 7168) ? 2 : ((colt >= 1280 && colt < 2560) ? 1 : 0);
        const int col0 = colt + wc * 32 + 8 * fq;
#pragma unroll
        for (int ai = 0; ai < 2; ++ai)
#pragma unroll
            for (int m = 0; m < 4; ++m) { const int lrow = row0 + ai * HALF + m * 16; const int pos = lrow & 2047, bb = lrow >> 11;
#pragma unroll
                for (int bj = 0; bj < 2; ++bj) { f32x4 v0 = acc[ai][bj][m][0], v1 = acc[ai][bj][m][1];
                    const int col = col0 + bj * HALF; bf16_t* dst;
                    if (colt < 2560) { const int cc = col - (mode == 1 ? 1280 : 0); const int nb = cc / 80, c = cc - nb * 80; dst = (mode == 1 ? GL : XL) + ((size_t)(bb * 16 + nb) * 2048 + pos) * 80 + c; }
                    else if (colt < 7168) { const int cv = col - 5632; const int gh = cv >> 6; dst = VB + ((size_t)(bb * 24 + gh) * 2048 + permpos(pos, gh >> 3)) * 64 + (cv & 63); }
                    else dst = GT + (size_t)lrow * 2048 + (col - 7168);
                    if (mode == 1) {
#pragma unroll
                        for (int e = 0; e < 4; ++e) { v0[e] = gelu_tanh_f(v0[e]); v1[e] = gelu_tanh_f(v1[e]); } }
                    else if (mode == 2) {
                        unsigned q[8];
#pragma unroll
                        for (int e = 0; e < 4; ++e) { q[e] = (unsigned)(sigmoid_f(v0[e]) * 255.0f + 0.5f); q[4 + e] = (unsigned)(sigmoid_f(v1[e]) * 255.0f + 0.5f); }
                        u32x2 wq; wq.x = q[0] | (q[1] << 8) | (q[2] << 16) | (q[3] << 24); wq.y = q[4] | (q[5] << 8) | (q[6] << 16) | (q[7] << 24);
                        *(u32x2*)((unsigned char*)GT + (size_t)lrow * 2048 + (col - 7168)) = wq;
                        continue; }
                    u32x4 w; w.x = cvt_pk_bf16(v0[0], v0[1]); w.y = cvt_pk_bf16(v0[2], v0[3]); w.z = cvt_pk_bf16(v1[0], v1[1]); w.w = cvt_pk_bf16(v1[2], v1[3]);
                    *(u32x4*)dst = w; } }
    }
};
template <bool SECOND> struct EpiMerge {
    static constexpr bool PERM = true, AFTER_DRAIN = false;
    bf16_t* MG; const unsigned char* G; int ldg;
    __device__ __forceinline__ void operator()(const f32x4 (&acc)[2][2][4][2], const Unit& u, int wr, int wc, int fr, int fq) const {
        const int row0 = u.pm * BM + wr * 64 + fr, col0 = u.pn * BM + wc * 32 + 8 * fq;
#pragma unroll
        for (int ai = 0; ai < 2; ++ai)
#pragma unroll
            for (int m = 0; m < 4; ++m) { const size_t row = (size_t)(row0 + ai * HALF + m * 16);
#pragma unroll
                for (int bj = 0; bj < 2; ++bj) { const f32x4 v0 = acc[ai][bj][m][0], v1 = acc[ai][bj][m][1];
                    const u32x2 g = *(const u32x2*)(G + row * ldg + col0 + bj * HALF);
                    float o[8]; const float k255 = 1.0f / 255.0f;
                    o[0] = v0[0] * ((float)(g.x & 0xffu) * k255); o[1] = v0[1] * ((float)((g.x >> 8) & 0xffu) * k255); o[2] = v0[2] * ((float)((g.x >> 16) & 0xffu) * k255); o[3] = v0[3] * ((float)(g.x >> 24) * k255);
                    o[4] = v1[0] * ((float)(g.y & 0xffu) * k255); o[5] = v1[1] * ((float)((g.y >> 8) & 0xffu) * k255); o[6] = v1[2] * ((float)((g.y >> 16) & 0xffu) * k255); o[7] = v1[3] * ((float)(g.y >> 24) * k255);
                    bf16_t* dst = MG + row * 1024 + col0 + bj * HALF;
                    if (SECOND) { const u32x4 p = *(const u32x4*)dst;
                        o[0] += bf_lo(p.x); o[1] += bf_hi(p.x); o[2] += bf_lo(p.y); o[3] += bf_hi(p.y); o[4] += bf_lo(p.z); o[5] += bf_hi(p.z); o[6] += bf_lo(p.w); o[7] += bf_hi(p.w); }
                    u32x4 w; w.x = cvt_pk_bf16(o[0], o[1]); w.y = cvt_pk_bf16(o[2], o[3]); w.z = cvt_pk_bf16(o[4], o[5]); w.w = cvt_pk_bf16(o[6], o[7]);
                    *(u32x4*)dst = w; } }
    }
};
struct EpiWo {
    static constexpr bool PERM = false, AFTER_DRAIN = false;
    const float* xp; const float* xs; float* OUT; bf16_t* XB; float* SS; int grow0;
    __device__ __forceinline__ void operator()(const f32x4 (&acc)[2][2][4][2], const Unit& u, int wr, int wc, int fr, int fq) const {
        const int row0 = u.pm * BM + wr * 64 + fr, col0 = u.pn * BM + wc * 32 + 4 * fq;
#pragma unroll
        for (int ai = 0; ai < 2; ++ai)
#pragma unroll
            for (int m = 0; m < 4; ++m) { const int lrow = row0 + ai * HALF + m * 16; const int grow = grow0 + lrow;
                const float* xr = (grow < 65536) ? xp + (size_t)grow * 1024 : xs + (size_t)(grow - 65536) * 1024;
                bf16_t* brow = XB + (size_t)lrow * 1024; float ss = 0.f;
#pragma unroll
                for (int bj = 0; bj < 2; ++bj)
#pragma unroll
                    for (int n = 0; n < 2; ++n) { const int c = col0 + bj * HALF + n * 16; const f32x4 xv = *(const f32x4*)(xr + c); const f32x4 o = xv + acc[ai][bj][m][n];
                        ss += (o[0] * o[0] + o[1] * o[1]) + (o[2] * o[2] + o[3] * o[3]);
                        u32x2 w; w.x = cvt_pk_bf16(o[0], o[1]); w.y = cvt_pk_bf16(o[2], o[3]); *(u32x2*)(brow + c) = w; }
                ss += __shfl_xor(ss, 16); ss += __shfl_xor(ss, 32);
                if (fq == 0) atomicAdd(SS + grow, ss); }
    }
};
struct EpiUp {
    static constexpr bool PERM = true, AFTER_DRAIN = false;
    bf16_t* O; const float* SS; int grow0;
    __device__ __forceinline__ void operator()(const f32x4 (&acc)[2][2][4][2], const Unit& u, int wr, int wc, int fr, int fq) const {
        const int row0 = u.pm * BM + wr * 64 + fr, col0 = u.pn * BM + wc * 32 + 8 * fq;
#pragma unroll
        for (int ai = 0; ai < 2; ++ai)
#pragma unroll
            for (int m = 0; m < 4; ++m) { const int lrow = row0 + ai * HALF + m * 16; const float rs = __builtin_amdgcn_rsqf(SS[grow0 + lrow] * (1.0f / 1024.0f) + 1e-6f);
                bf16_t* rowp = O + (size_t)lrow * 6144 + col0;
#pragma unroll
                for (int bj = 0; bj < 2; ++bj) { const f32x4 v0 = acc[ai][bj][m][0] * rs, v1 = acc[ai][bj][m][1] * rs;
                    u32x4 w; w.x = cvt_pk_bf16(v0[0], v0[1]); w.y = cvt_pk_bf16(v0[2], v0[3]); w.z = cvt_pk_bf16(v1[0], v1[1]); w.w = cvt_pk_bf16(v1[2], v1[3]);
                    *(u32x4*)(rowp + bj * HALF) = w; }
                asm volatile("" ::: "memory"); }
    }
};
struct EpiUpFused {
    static constexpr bool PERM = true, AFTER_DRAIN = false;
    bf16_t* H; const float* SS; int grow0; const float* cw; const float* cb; float* SB;
    __device__ __forceinline__ void operator()(const f32x4 (&acc)[2][2][4][2], const Unit& u, int wr, int wc, int fr, int fq) const {
        const int row0 = u.pm * BM + wr * 64 + fr, ch0 = u.pn * HALF + wc * 32 + 8 * fq;
#pragma unroll
        for (int ai = 0; ai < 2; ++ai) {
            float rs[4];
#pragma unroll
            for (int m = 0; m < 4; ++m) rs[m] = __builtin_amdgcn_rsqf(SS[grow0 + row0 + ai * HALF + m * 16] * (1.0f / 1024.0f) + 1e-6f);
            const int er = ((u.pm * 4 + 2 * ai + wr) * 2) * 9216;
#pragma unroll
            for (int n = 0; n < 2; ++n) {
                const int ch = ch0 + 4 * n;
                const f32x4 w0 = *(const f32x4*)(cw + ch), w1 = *(const f32x4*)(cw + 3072 + ch), w2 = *(const f32x4*)(cw + 6144 + ch), bb = *(const f32x4*)(cb + ch);
                float o[4][4], pp[4][4], gg[4][4];
#pragma unroll
                for (int e = 0; e < 4; ++e) {
                    float g[4], R[4], L[4];
#pragma unroll
                    for (int m = 0; m < 4; ++m) { g[m] = acc[ai][0][m][n][e] * rs[m];
                        R[m] = __builtin_bit_cast(float, __builtin_amdgcn_mov_dpp(__builtin_bit_cast(int, g[m]), 0x121, 0xf, 0xf, true)); L[m] = __builtin_bit_cast(float, __builtin_amdgcn_mov_dpp(__builtin_bit_cast(int, g[m]), 0x12F, 0xf, 0xf, true)); }
#pragma unroll
                    for (int m = 0; m < 4; ++m) {
                        const float gp = (fr == 0) ? (m > 0 ? R[m > 0 ? m - 1 : 0] : 0.f) : R[m];
                        const float gn = (fr == 15) ? (m < 3 ? L[m < 3 ? m + 1 : 3] : 0.f) : L[m];
                        const float pre = bb[e] + w0[e] * gp + w1[e] * g[m] + w2[e] * gn;
                        pp[m][e] = pre; gg[m][e] = g[m];
                        o[m][e] = gelu_tanh_f(pre) * (acc[ai][1][m][n][e] * rs[m]);
                    }
                }
#pragma unroll
                for (int m = 0; m < 4; ++m) {
                    const bool edge = (m == 0 && fr == 0) || (m == 3 && fr == 15);
                    if (!edge) { u32x2 w; w.x = cvt_pk_bf16(o[m][0], o[m][1]); w.y = cvt_pk_bf16(o[m][2], o[m][3]); *(u32x2*)(H + (size_t)(row0 + ai * HALF + m * 16) * 3072 + ch) = w; }
                }
                if (fr == 0) { float* sb = SB + er + ch;
                    *(f32x4*)(sb) = (f32x4){gg[0][0], gg[0][1], gg[0][2], gg[0][3]}; *(f32x4*)(sb + 3072) = (f32x4){pp[0][0], pp[0][1], pp[0][2], pp[0][3]};
                    *(f32x4*)(sb + 6144) = (f32x4){acc[ai][1][0][n][0] * rs[0], acc[ai][1][0][n][1] * rs[0], acc[ai][1][0][n][2] * rs[0], acc[ai][1][0][n][3] * rs[0]}; }
                if (fr == 15) { float* sb = SB + er + 9216 + ch;
                    *(f32x4*)(sb) = (f32x4){gg[3][0], gg[3][1], gg[3][2], gg[3][3]}; *(f32x4*)(sb + 3072) = (f32x4){pp[3][0], pp[3][1], pp[3][2], pp[3][3]};
                    *(f32x4*)(sb + 6144) = (f32x4){acc[ai][1][3][n][0] * rs[3], acc[ai][1][3][n][1] * rs[3], acc[ai][1][3][n][2] * rs[3], acc[ai][1][3][n][3] * rs[3]}; }
            }
            asm volatile("" ::: "memory");
        }
    }
};
struct EpiDown {
    static constexpr bool PERM = false, AFTER_DRAIN = false;
    float* OUT; const bf16_t* XB; int grow0;
    __device__ __forceinline__ void operator()(const f32x4 (&acc)[2][2][4][2], const Unit& u, int wr, int wc, int fr, int fq) const {
        const int row0 = u.pm * BM + wr * 64 + fr, col0 = u.pn * BM + wc * 32 + 4 * fq;
#pragma unroll
        for (int ai = 0; ai < 2; ++ai)
#pragma unroll
            for (int m = 0; m < 4; ++m) { const int lrow = row0 + ai * HALF + m * 16; float* orow = OUT + (size_t)(grow0 + lrow) * 1024; const bf16_t* brow = XB + (size_t)lrow * 1024;
#pragma unroll
                for (int bj = 0; bj < 2; ++bj)
#pragma unroll
                    for (int n = 0; n < 2; ++n) { const int c = col0 + bj * HALF + n * 16; const u32x2 xw = *(const u32x2*)(brow + c);
                        const f32x4 xv = (f32x4){bf_lo(xw.x), bf_hi(xw.x), bf_lo(xw.y), bf_hi(xw.y)}; *(f32x4*)(orow + c) = xv + acc[ai][bj][m][n]; } }
    }
};
template <class Epi, class Sched, bool ALIGN_EPI = false, bool SP2 = false>
__device__ __forceinline__ void gemm_phase(PG8_LAS unsigned char* lds, const Gemm g, const Sched& S, const Epi& E) {
    int tid_ = threadIdx.x; asm volatile("" : "+v"(tid_));
    const int tid = tid_, wid = __builtin_amdgcn_readfirstlane(tid >> 6), lane = tid & 63, wr = wid >> 2, wc = wid & 3, fr = lane & 15, fq = lane >> 4;
    const int K = g.K, nt = K / BK;
    unsigned voffA[2], voffB[2];
#pragma unroll
    for (int i = 0; i < 2; ++i) { int R, C; stage_rc(tid * 16 + i * 8192, R, C); const int Rb = Epi::PERM ? ((R & ~31) + perm32(R & 31)) : R;
        voffA[i] = (unsigned)(R * K + C) * 2u; voffB[i] = (unsigned)(Rb * K + C) * 2u; }
    const size_t kstep = (size_t)(BK * 2);
    const size_t hstep = (size_t)HALF * K * 2;
    const size_t tstep = 2 * hstep;
    const unsigned ldsw = (unsigned)wid * 1024u;
    const int aoff = lds_byte(wr * 64 + fr, fq * 8), boff = lds_byte(wc * 32 + fr, fq * 8);
#define PG8_SA(b, h) (((b) * 2 + (h)) * HTB)
#define PG8_SB(b, h) ((4 + (b) * 2 + (h)) * HTB)
#define PG8_STAGE(bufoff, gbase, voff) do { _Pragma("unroll") for (int _i = 0; _i < 2; ++_i) \
        __builtin_amdgcn_global_load_lds((const unsigned*)((const char*)(gbase) + (voff)[_i]), (PG8_LAS unsigned*)(lds + (bufoff) + ldsw + _i * 8192), 16, 0, 0); } while (0)
#define PG8_LDA(dst, b, h) do { _Pragma("unroll") for (int m = 0; m < 4; ++m) _Pragma("unroll") for (int k = 0; k < 2; ++k) dst[m][k] = *(const PG8_LAS bf16x8*)(lds + PG8_SA(b, h) + aoff + m * 2048 + k * 1024); } while (0)
#define PG8_LDB(dst, b, h) do { _Pragma("unroll") for (int n = 0; n < 2; ++n) _Pragma("unroll") for (int k = 0; k < 2; ++k) dst[n][k] = *(const PG8_LAS bf16x8*)(lds + PG8_SB(b, h) + boff + n * 2048 + k * 1024); } while (0)
#define PG8_MMA(ai, bj, At, Bt) do { __builtin_amdgcn_s_setprio(1); _Pragma("unroll") for (int m = 0; m < 4; ++m) _Pragma("unroll") for (int n = 0; n < 2; ++n) _Pragma("unroll") for (int k = 0; k < 2; ++k) \
        acc[ai][bj][m][n] = __builtin_amdgcn_mfma_f32_16x16x32_bf16(Bt[n][k], At[m][k], acc[ai][bj][m][n], 0, 0, 0); __builtin_amdgcn_s_setprio(0); } while (0)
#define PG8_WAIT_V(n) asm volatile("s_waitcnt vmcnt(" #n ")" ::: "memory")
#define PG8_WAIT_L(n) asm volatile("s_waitcnt lgkmcnt(" #n ")" ::: "memory")
#define PG8_BAR __builtin_amdgcn_s_barrier()
#define PG8_SCHED __builtin_amdgcn_sched_barrier(0)
    Unit cur, nxt; int ui = 0;
    if (!S.next(0, cur)) return;
    f32x4 acc[2][2][4][2];
#pragma unroll
    for (int a = 0; a < 2; ++a)
#pragma unroll
        for (int b = 0; b < 2; ++b)
#pragma unroll
            for (int m = 0; m < 4; ++m)
#pragma unroll
                for (int n = 0; n < 2; ++n) acc[a][b][m][n] = (f32x4){0.f, 0.f, 0.f, 0.f};
    bf16x8 At[4][2], B0[2][2], B1[2][2];
    const char* cA = (const char*)g.A + (size_t)cur.pm * tstep; const char* cB = (const char*)g.Bt + (size_t)cur.pn * tstep;
    S.a_ready(cur);
    if constexpr (SP2) {
        PG8_STAGE(PG8_SB(0, 0), cB, voffB); PG8_STAGE(PG8_SB(0, 1), cB + hstep, voffB); PG8_STAGE(PG8_SA(0, 0), cA, voffA); PG8_STAGE(PG8_SA(0, 1), cA + hstep, voffA);
        if (wr == 1) PG8_BAR;
        PG8_WAIT_V(2); PG8_BAR;
        PG8_STAGE(PG8_SB(1, 0), cB + kstep, voffB); PG8_STAGE(PG8_SA(1, 0), cA + kstep, voffA); PG8_STAGE(PG8_SB(1, 1), cB + hstep + kstep, voffB);
        PG8_WAIT_V(6); PG8_BAR;
    } else {
        PG8_STAGE(PG8_SB(0, 0), cB, voffB); PG8_STAGE(PG8_SA(0, 0), cA, voffA); PG8_STAGE(PG8_SB(0, 1), cB + hstep, voffB); PG8_STAGE(PG8_SA(0, 1), cA + hstep, voffA);
        if (wr == 1) PG8_BAR;
        PG8_WAIT_V(4); PG8_BAR;
        PG8_STAGE(PG8_SB(1, 0), cB + kstep, voffB); PG8_STAGE(PG8_SA(1, 0), cA + kstep, voffA); PG8_STAGE(PG8_SB(1, 1), cB + hstep + kstep, voffB);
        PG8_WAIT_V(6); PG8_BAR;
    }
    for (;;) {
        const bool has_next = S.next(ui + 1, nxt);
        const char* nA = has_next ? (const char*)g.A + (size_t)nxt.pm * tstep : cA; const char* nB = has_next ? (const char*)g.Bt + (size_t)nxt.pn * tstep : cB;
        for (int t = 0; t < nt; t += 2) {
            const bool last = (t == nt - 2);
            const char* a1 = cA + (size_t)(t + 1) * kstep;
            const char* a2 = last ? nA : cA + (size_t)(t + 2) * kstep; const char* b2 = last ? nB : cB + (size_t)(t + 2) * kstep;
            const char* a3 = a2 + kstep; const char* b3 = b2 + kstep;
            if (last && has_next) S.a_ready(nxt);
            if constexpr (SP2) {
            PG8_LDB(B0, 0, 0); PG8_LDB(B1, 0, 1); PG8_SCHED; PG8_LDA(At, 0, 0); PG8_STAGE(PG8_SA(1, 1), a1 + hstep, voffA);
            PG8_WAIT_V(8); PG8_WAIT_L(0); PG8_BAR; PG8_MMA(0, 0, At, B0); PG8_MMA(0, 1, At, B1); PG8_BAR; PG8_SCHED;
            PG8_LDA(At, 0, 1); PG8_STAGE(PG8_SB(0, 0), b2, voffB); PG8_STAGE(PG8_SB(0, 1), b2 + hstep, voffB); PG8_STAGE(PG8_SA(0, 0), a2, voffA);
            PG8_WAIT_V(8); PG8_WAIT_L(0); PG8_BAR; PG8_MMA(1, 0, At, B0); PG8_MMA(1, 1, At, B1); PG8_BAR; PG8_SCHED;
            PG8_LDB(B0, 1, 0); PG8_LDB(B1, 1, 1); PG8_SCHED; PG8_LDA(At, 1, 0); PG8_STAGE(PG8_SA(0, 1), a2 + hstep, voffA);
            PG8_WAIT_V(8); PG8_WAIT_L(0); PG8_BAR; PG8_MMA(0, 0, At, B0); PG8_MMA(0, 1, At, B1); PG8_BAR; PG8_SCHED;
            PG8_LDA(At, 1, 1); PG8_STAGE(PG8_SB(1, 0), b3, voffB); PG8_STAGE(PG8_SB(1, 1), b3 + hstep, voffB); PG8_STAGE(PG8_SA(1, 0), a3, voffA);
            PG8_WAIT_V(8); PG8_WAIT_L(0); PG8_BAR; PG8_MMA(1, 0, At, B0); PG8_MMA(1, 1, At, B1); PG8_BAR; PG8_SCHED;
            } else {
            PG8_LDB(B0, 0, 0); PG8_SCHED; PG8_LDA(At, 0, 0); PG8_STAGE(PG8_SA(1, 1), a1 + hstep, voffA);
            PG8_WAIT_L(8); PG8_BAR; PG8_WAIT_L(0); PG8_MMA(0, 0, At, B0); PG8_BAR; PG8_SCHED;
            PG8_LDB(B1, 0, 1); PG8_STAGE(PG8_SB(0, 0), b2, voffB);
            PG8_BAR; PG8_WAIT_L(0); PG8_MMA(0, 1, At, B1); PG8_BAR;
            PG8_LDA(At, 0, 1); PG8_STAGE(PG8_SA(0, 0), a2, voffA);
            PG8_BAR; PG8_WAIT_L(0); PG8_MMA(1, 0, At, B0); PG8_BAR; PG8_SCHED;
            PG8_STAGE(PG8_SB(0, 1), b2 + hstep, voffB);
            PG8_WAIT_V(6); PG8_BAR; PG8_MMA(1, 1, At, B1); PG8_BAR;
            PG8_LDB(B0, 1, 0); PG8_SCHED; PG8_LDA(At, 1, 0); PG8_STAGE(PG8_SA(0, 1), a2 + hstep, voffA);
            PG8_WAIT_L(8); PG8_BAR; PG8_WAIT_L(0); PG8_MMA(0, 0, At, B0); PG8_BAR; PG8_SCHED;
            PG8_LDB(B1, 1, 1); PG8_STAGE(PG8_SB(1, 0), b3, voffB);
            PG8_BAR; PG8_WAIT_L(0); PG8_MMA(0, 1, At, B1); PG8_BAR;
            PG8_LDA(At, 1, 1); PG8_STAGE(PG8_SA(1, 0), a3, voffA);
            PG8_BAR; PG8_WAIT_L(0); PG8_MMA(1, 0, At, B0); PG8_BAR; PG8_SCHED;
            PG8_STAGE(PG8_SB(1, 1), b3 + hstep, voffB);
            PG8_WAIT_V(6); PG8_BAR; PG8_MMA(1, 1, At, B1); PG8_BAR;
            }
        }
        if constexpr (ALIGN_EPI) { if (wr == 0) PG8_BAR; }
        if constexpr (!Epi::AFTER_DRAIN) { E(acc, cur, wr, wc, fr, fq); S.done(cur); }
        if (!has_next) break;
#pragma unroll
        for (int a = 0; a < 2; ++a)
#pragma unroll
            for (int b = 0; b < 2; ++b)
#pragma unroll
                for (int m = 0; m < 4; ++m)
#pragma unroll
                    for (int n = 0; n < 2; ++n) acc[a][b][m][n] = (f32x4){0.f, 0.f, 0.f, 0.f};
        cur = nxt; cA = nA; cB = nB; ++ui;
        if constexpr (ALIGN_EPI) { if (wr == 1) PG8_BAR; }
    }
    PG8_WAIT_V(0);
    if constexpr (!ALIGN_EPI) { if (wr == 0) PG8_BAR; }
    PG8_BAR;
    if constexpr (Epi::AFTER_DRAIN) { E.fused(acc, cur, wr, wc, fr, fq, lds, wid, lane); S.done(cur); }
#undef PG8_SA
#undef PG8_SB
#undef PG8_STAGE
#undef PG8_LDA
#undef PG8_LDB
#undef PG8_MMA
#undef PG8_WAIT_V
#undef PG8_WAIT_L
#undef PG8_BAR
#undef PG8_SCHED
}
}

#define DI __device__ __forceinline__
#define LAS __attribute__((address_space(3)))
typedef unsigned short bf16;
typedef unsigned v4u __attribute__((ext_vector_type(4)));
typedef unsigned v2u __attribute__((ext_vector_type(2)));
typedef float f32x4 __attribute__((ext_vector_type(4)));
typedef float f32x16 __attribute__((ext_vector_type(16)));
typedef short bf16x8 __attribute__((ext_vector_type(8)));

#ifndef PHM
#define PHM 0xFFFF
#endif
#ifndef REP
#define REP 0
#endif
constexpr int NWAVES = 8;
constexpr int S_ = 2048, D_ = 1024, NSEQ = 40, NTOK = NSEQ * S_;
constexpr int INC = 9216, C_LX = 0, C_LG = 1280, C_Q = 2560, C_K = 4096, C_V = 5632, C_GA = 7168, C_GB = 8192;
constexpr int DFF = 3072;
constexpr int PITCH = INC + 64;
constexpr float EPS_ = 1e-6f;
constexpr float QSCALE = 0.125f * 1.4426950408889634f;

constexpr size_t MiB = 1u << 20;
constexpr size_t WS_CTL = 0, CTL_BYTES = 1 * MiB;
constexpr size_t CTL_SS = 16384;
constexpr size_t WS_WIN = 1 * MiB, WS_WUP = 19 * MiB, WS_WDN = 31 * MiB, WS_WO = 37 * MiB, WS_WLO = 39 * MiB, WS_WAO = 42 * MiB, WS_WG = 43 * MiB, WS_ROPE = 44 * MiB, WS_ACT = 45 * MiB;
constexpr size_t ACT_PER_TOK = 2048 + 2048 + 16384;

constexpr int LDS_BYTES = 147456, RING_BYTES = 131072, MISC_OFF = 147456 - 256;

DI unsigned f2bf(float f) { unsigned u = __builtin_bit_cast(unsigned, f); return (u + 0x7fffu + ((u >> 16) & 1u)) >> 16; }
typedef float f32x2_t __attribute__((ext_vector_type(2))); typedef __bf16 bf16x2_t __attribute__((ext_vector_type(2)));
DI unsigned pk2(float lo, float hi) { f32x2_t v = {lo, hi}; bf16x2_t b = __builtin_convertvector(v, bf16x2_t); return __builtin_bit_cast(unsigned, b); }
DI float bflo(unsigned w) { return __uint_as_float(w << 16); }
DI float bfhi(unsigned w) { return __uint_as_float(w & 0xffff0000u); }
DI float bf1(unsigned short h) { return __uint_as_float(((unsigned)h) << 16); }
DI float frcp(float x) { return __builtin_amdgcn_rcpf(x); }
DI float sigm(float x) { return frcp(1.0f + __expf(-x)); }
DI float gelu_t(float x) { const float u = 0.7978845608028654f * (x + 0.044715f * x * x * x); return x * frcp(1.0f + __expf(-2.0f * u)); }
DI float wave_sum(float v) {
#pragma unroll
    for (int o = 1; o < 64; o <<= 1) v += __shfl_xor(v, o);
    return v;
}
DI float wave_max(float v) {
#pragma unroll
    for (int o = 1; o < 64; o <<= 1) v = fmaxf(v, __shfl_xor(v, o));
    return v;
}

struct Args { const float* in[21]; float* out; unsigned char* ws; int spc; int nch; int start[6]; int cnt[6]; };
enum { I_XP = 0, I_XS, I_N1G, I_WIN, I_LCW, I_LCB, I_LWA, I_LBA, I_LWX, I_LBX, I_LAM, I_WLO, I_QNG, I_KNG, I_WAO, I_WO, I_N2G, I_WUP, I_FCW, I_FCB, I_WDN };

#define AS4 __attribute__((address_space(4)))
struct KP { const AS4 unsigned char* p; };
DI KP kp_fresh() { const AS4 unsigned char* p = (const AS4 unsigned char*)__builtin_amdgcn_kernarg_segment_ptr(); asm volatile("" : "+s"(p)); KP k; k.p = p; return k; }
DI const float* kin(KP k, int i) { return *(const float* const AS4*)(k.p + 8 * i); }
DI float* kout(KP k) { return *(float* const AS4*)(k.p + 168); }
DI unsigned char* kws(KP k) { return *(unsigned char* const AS4*)(k.p + 176); }
DI int kspc(KP k) { return *(const AS4 int*)(k.p + 184); }
DI int knch(KP k) { return *(const AS4 int*)(k.p + 188); }
DI int kstart(KP k, int c) { return *(const AS4 int*)(k.p + 192 + 4 * c); }
DI int kcnt(KP k, int c) { return *(const AS4 int*)(k.p + 216 + 4 * c); }
DI int launder_i(int v) { asm volatile("" : "+s"(v)); return v; }
DI int launder_v(int v) { asm volatile("" : "+v"(v)); return v; }
static_assert(sizeof(Args) == 240, "Args layout");
DI void p0_transpose_item(const float* W, int K, int N, bf16* WT, const float* kscale, LAS float* scr, int item, int lane, int perm = 0) {
    const int nblk = N / 32, kb = item / nblk, nb = item % nblk, k0 = 64 * kb, n0 = 32 * nb;
#pragma unroll 8
    for (int i = 0; i < 32; ++i) { const int kk = 2 * i + (lane >> 5); float v = W[(size_t)(k0 + kk) * N + n0 + (lane & 31)]; if (kscale) v *= kscale[k0 + kk]; scr[kk * 33 + (lane & 31)] = v; }
    asm volatile("s_waitcnt lgkmcnt(0)" ::: "memory");
    const int c = lane & 7;
#pragma unroll
    for (int j = 0; j < 4; ++j) { const int n = (lane >> 3) + 8 * j; const LAS float* s = scr + (8 * c) * 33 + n;
        v4u o; o.x = pk2(s[0 * 33], s[1 * 33]); o.y = pk2(s[2 * 33], s[3 * 33]); o.z = pk2(s[4 * 33], s[5 * 33]); o.w = pk2(s[6 * 33], s[7 * 33]);
        int orow = n0 + n; if (perm == 1) { const int chn = orow % 3072; orow = 256 * (chn >> 7) + (orow >= 3072 ? 128 : 0) + (chn & 127); }
        if (perm == 2 && orow >= 2560 && orow < 5632) { const int cc = orow & 255; orow = (orow & ~255) + 128 * ((cc >> 5) & 1) + 32 * (cc >> 6) + (cc & 31); }
        *(v4u*)(WT + (size_t)orow * K + k0 + 8 * c) = o; }
    asm volatile("s_waitcnt lgkmcnt(0)" ::: "memory");
}
DI void p0_weights(KP A, LAS unsigned char* lds, int tid, int wave, int lane, int G) {
    unsigned char* ws = kws(A);
    LAS float* scr = (LAS float*)(lds + wave * 16384);
    const int gw = blockIdx.x * NWAVES + wave, NGW = G * NWAVES;
    constexpr int I_IN = 16 * 288, I_UP = 16 * 192, I_DN = 48 * 32, I_O = 16 * 32, I_LO = 20 * 32, I_AO = 8 * 32;
    constexpr int NITEMS = I_IN + I_UP + I_DN + I_O + I_LO + I_AO;
    for (int it = gw; it < NITEMS; it += NGW) {
        int r = it;
        if (r < I_IN) { p0_transpose_item(kin(A, I_WIN), 1024, 9216, (bf16*)(ws + WS_WIN), nullptr, scr, r, lane, 2); continue; } r -= I_IN;
        if (r < I_UP) { p0_transpose_item(kin(A, I_WUP), 1024, 6144, (bf16*)(ws + WS_WUP), kin(A, I_N2G), scr, r, lane, 1); continue; } r -= I_UP;
        if (r < I_DN) { p0_transpose_item(kin(A, I_WDN), 3072, 1024, (bf16*)(ws + WS_WDN), nullptr, scr, r, lane); continue; } r -= I_DN;
        if (r < I_O) { p0_transpose_item(kin(A, I_WO), 1024, 1024, (bf16*)(ws + WS_WO), nullptr, scr, r, lane); continue; } r -= I_O;
        if (r < I_LO) { p0_transpose_item(kin(A, I_WLO), 1280, 1024, (bf16*)(ws + WS_WLO), nullptr, scr, r, lane); continue; } r -= I_LO;
        p0_transpose_item(kin(A, I_WAO), 512, 1024, (bf16*)(ws + WS_WAO), nullptr, scr, r, lane);
    }
    const int gt = blockIdx.x * (NWAVES * 64) + tid, NGT = G * NWAVES * 64;
    bf16* WG = (bf16*)(ws + WS_WG);
    for (int i = gt; i < 16 * 2 * 2 * 80 * 96; i += NGT) {
        const int k = i % 96, n = (i / 96) % 80, ty = (i / (96 * 80)) & 1, dir = (i / (96 * 80 * 2)) & 1, nb = i / (96 * 80 * 4);
        float v = 0.f; if (k < 80) v = (ty ? kin(A, I_LWX) : kin(A, I_LWA))[((size_t)(dir * 16 + nb) * 80 + k) * 80 + n];
        WG[i] = (bf16)f2bf(v * 1.4426950408889634f);
    }
    float* RT = (float*)(ws + WS_ROPE);
    for (int i = gt; i < 2048 * 8; i += NGT) {
        const int pos = i >> 3, fi = i & 7;
        const double inv = fi == 0 ? 1.0 : fi == 1 ? 0.19392274474868576 : fi == 2 ? 0.03760603093086393 : fi == 3 ? 0.007292664737217109 : fi == 4 ? 0.001414213562373095 : fi == 5 ? 0.0002742481756762073 : fi == 6 ? 5.318295896944988e-05 : 1.031338537721246e-05;
        const float angf = (float)pos * (float)inv;
        const double rev = (double)angf * 0.15915494309189535; const float fr = (float)(rev - __builtin_rint(rev));
        RT[2 * i] = __builtin_amdgcn_cosf(fr); RT[2 * i + 1] = __builtin_amdgcn_sinf(fr);
    }
}
DI void p0_xn(KP A, bf16* XN, int grow0, int Tc, int wave, int lane, int G) {
    const int gw = blockIdx.x * NWAVES + wave, NGW = G * NWAVES;
    const f32x4* gp = (const f32x4*)kin(A, I_N1G) + lane;
    f32x4 g[4];
#pragma unroll
    for (int j = 0; j < 4; ++j) g[j] = gp[64 * j];
    for (int m = gw; m < Tc; m += NGW) {
        const int grow = grow0 + m; const float* xr = (grow < 65536) ? kin(A, I_XP) + (size_t)grow * 1024 : kin(A, I_XS) + (size_t)(grow - 65536) * 1024;
        const f32x4* xv = (const f32x4*)xr + lane; f32x4 v[4]; float s = 0.f;
#pragma unroll
        for (int j = 0; j < 4; ++j) { v[j] = xv[64 * j]; s += (v[j].x * v[j].x + v[j].y * v[j].y) + (v[j].z * v[j].z + v[j].w * v[j].w); }
        const float rs = __builtin_amdgcn_rsqf(wave_sum(s) * (1.0f / 1024.0f) + EPS_);
        v2u* o8 = (v2u*)(XN + (size_t)m * 1024) + lane;
#pragma unroll
        for (int j = 0; j < 4; ++j) { v2u w; w.x = pk2(v[j].x * rs * g[j].x, v[j].y * rs * g[j].y); w.y = pk2(v[j].z * rs * g[j].z, v[j].w * rs * g[j].w); o8[64 * j] = w; }
    }
}

DI void p1b_qknorm_vt(KP A, const bf16* VB, bf16* VT, int Tc, LAS unsigned char* lds, int wave, int lane, int G) {
    const int gw = blockIdx.x * NWAVES + wave, NGW = G * NWAVES;
    const float* RT = (const float*)(kws(A) + WS_ROPE);
    const int c8 = lane & 7, hv0 = lane >> 3;
    LAS unsigned short* tile = (LAS unsigned short*)(lds + wave * 16384);
    const int nseq = Tc / S_, nitems = nseq * 24 * 32;
    for (int it = gw; it < nitems; it += NGW) {
        const int u = it & 31, gh = (it >> 5) % 24, b = it / (32 * 24);
        const int grp = gh >> 3, dsh = grp * 2, dil = 1 << dsh, L = S_ >> dsh;
        const int pi0 = 64 * u, mm = pi0 / L, j0 = pi0 % L;
#pragma unroll
        for (int i = 0; i < 8; ++i) { const int r = (lane >> 3) + 8 * i;
            const v4u w = *(const v4u*)(VB + ((size_t)(b * 24 + gh) * S_ + pi0 + r) * 64 + c8 * 8);
            LAS unsigned* dst = (LAS unsigned*)(tile + r * 66 + c8 * 8); dst[0] = w.x; dst[1] = w.y; dst[2] = w.z; dst[3] = w.w; }
        asm volatile("s_waitcnt lgkmcnt(0)" ::: "memory");
#pragma unroll
        for (int i = 0; i < 8; ++i) { const int d = (lane >> 3) + 8 * i; const LAS unsigned short* s = tile + (8 * c8) * 66 + d;
            v4u o; o.x = (unsigned)s[0] | ((unsigned)s[66] << 16); o.y = (unsigned)s[2 * 66] | ((unsigned)s[3 * 66] << 16); o.z = (unsigned)s[4 * 66] | ((unsigned)s[5 * 66] << 16); o.w = (unsigned)s[6 * 66] | ((unsigned)s[7 * 66] << 16);
            *(v4u*)(VT + (((size_t)(b * 24 + gh) * 64 + (pi0 >> 5) + (c8 >> 2)) * 64 + d) * 32 + 8 * (c8 & 3)) = o; }
        asm volatile("s_waitcnt lgkmcnt(0)" ::: "memory");
    }
}

constexpr int LRU_CW = 132096;
constexpr int LRU_XR = 0, LRU_XR_SZ = 20992, LRU_XCB = 2 * LRU_XR_SZ, LRU_XCB_SZ = 24576, LRU_HST = LRU_XCB + 2 * LRU_XCB_SZ, LRU_HST_SZ = 20480;
static_assert(LRU_HST + 2 * LRU_HST_SZ <= LRU_CW && LRU_CW + 3200 <= MISC_OFF, "lru lds");
struct LruUnit { const bf16* wrp; const bf16* wip; float ba, bx, kk, hc; };
DI void lru_unit_setup(LruUnit& U, KP A, int nb, int dir, int cb, int lane) {
    const bf16* WG = (const bf16*)(kws(A) + WS_WG);
    const int n = 16 * cb + (lane & 15), kq = lane >> 4;
    U.wrp = WG + ((size_t)((nb * 2 + dir) * 2 + 0) * 80 + n) * 96 + 8 * kq;
    U.wip = WG + ((size_t)((nb * 2 + dir) * 2 + 1) * 80 + n) * 96 + 8 * kq;
    const int ch = dir * 1280 + 80 * nb + n;
    U.ba = kin(A, I_LBA)[ch] * 1.4426950408889634f; U.bx = kin(A, I_LBX)[ch] * 1.4426950408889634f;
    const float lam = kin(A, I_LAM)[ch]; const float nl = -lam; const float sp = fmaxf(nl, 0.f) + log1pf(__expf(-fabsf(nl)));
    U.kk = -8.0f * sp * 1.4426950408889634f; U.hc = 0.f;
}
DI void lru_unit_run(LruUnit& U, const bf16x8 (&wr)[3], const bf16x8 (&wi)[3], LAS unsigned char* xcb, LAS unsigned char* hst, int cb, int lane) {
    const int c = lane & 15, q = lane >> 4;
    float hc = U.hc;
#pragma unroll 1
    for (int half = 0; half < 2; ++half) {
        float av[4][4], bv[4][4], Ac[4], Bc[4];
#pragma unroll
        for (int t = 0; t < 4; ++t) {
            const int tb = 4 * half + t;
            f32x4 ar = {0.f, 0.f, 0.f, 0.f}, ai = {0.f, 0.f, 0.f, 0.f};
#pragma unroll
            for (int ks = 0; ks < 3; ++ks) {
                const bf16x8 a = *(const LAS bf16x8*)(xcb + (16 * tb + c) * 192 + (32 * ks + 8 * q) * 2);
                ar = __builtin_amdgcn_mfma_f32_16x16x32_bf16(a, wr[ks], ar, 0, 0, 0);
                ai = __builtin_amdgcn_mfma_f32_16x16x32_bf16(a, wi[ks], ai, 0, 0, 0);
            }
#pragma unroll
            for (int e = 0; e < 4; ++e) {
                const int s = 16 * tb + 4 * q + e;
                const float xc = bf1(*(const LAS unsigned short*)(xcb + s * 192 + (16 * cb + c) * 2));
                const float r = frcp(1.0f + __builtin_amdgcn_exp2f(-(ar[e] + U.ba))), ig = frcp(1.0f + __builtin_amdgcn_exp2f(-(ai[e] + U.bx)));
                const float a = __builtin_amdgcn_exp2f(U.kk * r);
                av[t][e] = a; bv[t][e] = __builtin_amdgcn_sqrtf(fmaxf(1.0f - a * a, 0.f)) * ig * xc;
            }
            Ac[t] = av[t][0] * av[t][1] * av[t][2] * av[t][3];
            Bc[t] = ((bv[t][0] * av[t][1] + bv[t][1]) * av[t][2] + bv[t][2]) * av[t][3] + bv[t][3];
        }
#pragma unroll
        for (int t = 0; t < 4; ++t) { const float A1 = __shfl_up(Ac[t], 16), B1 = __shfl_up(Bc[t], 16); if (q >= 1) { Bc[t] = Ac[t] * B1 + Bc[t]; Ac[t] = A1 * Ac[t]; } }
#pragma unroll
        for (int t = 0; t < 4; ++t) { const float A2 = __shfl_up(Ac[t], 32), B2 = __shfl_up(Bc[t], 32); if (q >= 2) { Bc[t] = Ac[t] * B2 + Bc[t]; Ac[t] = A2 * Ac[t]; } }
        float At[4], Bt[4], Ae[4], Be[4];
#pragma unroll
        for (int t = 0; t < 4; ++t) { At[t] = __shfl(Ac[t], 48 + c); Bt[t] = __shfl(Bc[t], 48 + c); Ae[t] = __shfl_up(Ac[t], 16); Be[t] = __shfl_up(Bc[t], 16); }
#pragma unroll
        for (int t = 0; t < 4; ++t) {
            const int tb = 4 * half + t;
            float h = (q == 0) ? hc : (Ae[t] * hc + Be[t]);
#pragma unroll
            for (int e = 0; e < 4; ++e) { h = av[t][e] * h + bv[t][e]; *(LAS unsigned short*)(hst + (16 * tb + 4 * q + e) * 160 + (16 * cb + c) * 2) = (unsigned short)pk2(h, 0.f); }
            hc = At[t] * hc + Bt[t];
        }
    }
    U.hc = hc;
}
#define LBAR() do { asm volatile("s_waitcnt lgkmcnt(0)" ::: "memory"); __builtin_amdgcn_s_barrier(); asm volatile("" ::: "memory"); } while (0)
DI void lru_item(KP A, const bf16* XL, const bf16* GL, bf16* HG, int b, int nb, LAS unsigned char* lds, int tid, int wave, int lane) {
    const int dir = wave >> 2, dtid = tid & 255;
    LAS unsigned char* xr = lds + LRU_XR + dir * LRU_XR_SZ;
    LAS unsigned char* xcb = lds + LRU_XCB + dir * LRU_XCB_SZ;
    LAS unsigned char* hst = lds + LRU_HST + dir * LRU_HST_SZ;
    const size_t rowbase = (size_t)b * S_;
    LruUnit U0, U1;
    const int u0 = wave, u1 = wave + 8; const bool two = wave < 2;
    lru_unit_setup(U0, A, nb, u0 / 5, u0 % 5, lane);
    lru_unit_setup(U1, A, nb, two ? u1 / 5 : 0, two ? u1 % 5 : 0, lane);
    { const int r = dtid >> 1, hf = dtid & 1; LAS v4u* z = (LAS v4u*)(xcb + r * 192 + 160 + hf * 16); *z = (v4u){0u, 0u, 0u, 0u}; }
    LAS float* cw = (LAS float*)(lds + LRU_CW + dir * 1600);
    for (int i = dtid; i < 400; i += 256) { const int j = i / 80, cc = i % 80; cw[i] = (j < 4) ? kin(A, I_LCW)[j * 1280 + 80 * nb + cc] : kin(A, I_LCB)[80 * nb + cc]; }
    {
        const int t0 = dir ? 15 * 128 : 0;
#pragma unroll
        for (int i = 0; i < 6; ++i) { const int idx = dtid + 256 * i; if (idx < 1310) { const int row = idx / 10, c8 = idx % 10; const int t = t0 - 2 + row;
            v4u w = (v4u){0u, 0u, 0u, 0u}; if (t >= 0 && t < S_) w = *(const v4u*)(XL + ((size_t)(b * 16 + nb) * S_ + t) * 80 + 8 * c8);
            *(LAS v4u*)(xr + row * 160 + c8 * 16) = w; } }
    }
    __syncthreads();
    bf16x8 w0r[3], w0i[3], w1r[3], w1i[3];
#pragma unroll
    for (int ks = 0; ks < 3; ++ks) { w0r[ks] = *(const bf16x8*)(U0.wrp + 32 * ks); w0i[ks] = *(const bf16x8*)(U0.wip + 32 * ks); w1r[ks] = *(const bf16x8*)(U1.wrp + 32 * ks); w1i[ks] = *(const bf16x8*)(U1.wip + 32 * ks); }
#pragma unroll 1
    for (int it = 0; it < 16; ++it) {
        const int ti = dir ? 15 - it : it, t0 = ti * 128;
        const bool second = it >= 8;
        v4u nx[6];
        {
            const int tn = (dir ? ti - 1 : ti + 1) * 128; const int dt = launder_v(dtid);
#pragma unroll
            for (int i = 0; i < 6; ++i) { const int idx = dt + 256 * i; const int row = idx / 10, c8 = idx % 10; const int t = tn - 2 + row;
                nx[i] = (v4u){0u, 0u, 0u, 0u}; if (it < 15 && idx < 1310 && t >= 0 && t < S_) nx[i] = *(const v4u*)(XL + ((size_t)(b * 16 + nb) * S_ + t) * 80 + 8 * c8); }
        }
        if (dtid < 250) {
            const int dt = launder_v(dtid); const int c8 = dt % 10, trow = dt / 10; const int ch = 80 * nb + 8 * c8;
            float w[4][8], bb[8];
#pragma unroll
            for (int j = 0; j < 4; ++j) { const f32x4 a0 = *(const LAS f32x4*)(cw + j * 80 + 8 * c8), a1 = *(const LAS f32x4*)(cw + j * 80 + 8 * c8 + 4);
                w[j][0] = a0.x; w[j][1] = a0.y; w[j][2] = a0.z; w[j][3] = a0.w; w[j][4] = a1.x; w[j][5] = a1.y; w[j][6] = a1.z; w[j][7] = a1.w; }
            { const f32x4 a0 = *(const LAS f32x4*)(cw + 320 + 8 * c8), a1 = *(const LAS f32x4*)(cw + 320 + 8 * c8 + 4);
                bb[0] = a0.x; bb[1] = a0.y; bb[2] = a0.z; bb[3] = a0.w; bb[4] = a1.x; bb[5] = a1.y; bb[6] = a1.z; bb[7] = a1.w; }
#pragma unroll 1
            for (int o = trow; o < 128; o += 25) {
                float acc[8];
#pragma unroll
                for (int e = 0; e < 8; ++e) acc[e] = bb[e];
#pragma unroll
                for (int j = 0; j < 4; ++j) { const v4u xw = *(const LAS v4u*)(xr + (o + j) * 160 + c8 * 16);
                    acc[0] += w[j][0] * bflo(xw.x); acc[1] += w[j][1] * bfhi(xw.x); acc[2] += w[j][2] * bflo(xw.y); acc[3] += w[j][3] * bfhi(xw.y);
                    acc[4] += w[j][4] * bflo(xw.z); acc[5] += w[j][5] * bfhi(xw.z); acc[6] += w[j][6] * bflo(xw.w); acc[7] += w[j][7] * bfhi(xw.w); }
                const int s = dir ? 127 - o : o;
                v4u ow; ow.x = pk2(acc[0], acc[1]); ow.y = pk2(acc[2], acc[3]); ow.z = pk2(acc[4], acc[5]); ow.w = pk2(acc[6], acc[7]);
                *(LAS v4u*)(xcb + s * 192 + c8 * 16) = ow;
            }
        }
        LBAR();
        v4u gt[5], pt[5];
        { const int dt = launder_v(dtid);
#pragma unroll
        for (int i = 0; i < 5; ++i) { const int idx = dt + 256 * i; const int srow = idx / 10, c8 = idx % 10; const int t = t0 + (dir ? 127 - srow : srow);
            gt[i] = (v4u){0u, 0u, 0u, 0u}; pt[i] = (v4u){0u, 0u, 0u, 0u};
            if (second) { gt[i] = *(const v4u*)(GL + ((size_t)(b * 16 + nb) * S_ + t) * 80 + 8 * c8); pt[i] = *(const v4u*)(HG + (rowbase + t) * 1280 + 80 * nb + 8 * c8); } } }
        lru_unit_run(U0, w0r, w0i, lds + LRU_XCB + (u0 / 5) * LRU_XCB_SZ, lds + LRU_HST + (u0 / 5) * LRU_HST_SZ, u0 % 5, lane);
        if (two) lru_unit_run(U1, w1r, w1i, lds + LRU_XCB + (u1 / 5) * LRU_XCB_SZ, lds + LRU_HST + (u1 / 5) * LRU_HST_SZ, u1 % 5, lane);
        LBAR();
        const int dt2 = launder_v(dtid);
#pragma unroll
        for (int i = 0; i < 5; ++i) { const int idx = dt2 + 256 * i; const int srow = idx / 10, c8 = idx % 10; const int t = t0 + (dir ? 127 - srow : srow);
            v4u hw = *(const LAS v4u*)(hst + srow * 160 + c8 * 16);
            if (second) {
                v4u o;
                o.x = pk2((bflo(hw.x) + bflo(pt[i].x)) * bflo(gt[i].x), (bfhi(hw.x) + bfhi(pt[i].x)) * bfhi(gt[i].x));
                o.y = pk2((bflo(hw.y) + bflo(pt[i].y)) * bflo(gt[i].y), (bfhi(hw.y) + bfhi(pt[i].y)) * bfhi(gt[i].y));
                o.z = pk2((bflo(hw.z) + bflo(pt[i].z)) * bflo(gt[i].z), (bfhi(hw.z) + bfhi(pt[i].z)) * bfhi(gt[i].z));
                o.w = pk2((bflo(hw.w) + bflo(pt[i].w)) * bflo(gt[i].w), (bfhi(hw.w) + bfhi(pt[i].w)) * bfhi(gt[i].w));
                hw = o;
            }
            *(v4u*)(HG + (rowbase + t) * 1280 + 80 * nb + 8 * c8) = hw; }
        const int dt3 = launder_v(dtid);
#pragma unroll
        for (int i = 0; i < 6; ++i) { const int idx = dt3 + 256 * i; if (idx < 1310) { const int row = idx / 10, c8 = idx % 10; *(LAS v4u*)(xr + row * 160 + c8 * 16) = nx[i]; } }
        if (it == 7) __syncthreads(); else LBAR();
    }
}

DI int crow(int r, int hi) { return (r & 3) + 8 * (r >> 2) + 4 * hi; }
DI int swap23(int i) { return (i & ~12) | ((i & 4) << 1) | ((i & 8) >> 1); }
DI int colx(int x) { return x ^ ((x >> 5) & 15); }
template <int NT> DI void attn_run(const bf16* QB, const bf16* KB, const bf16* VT, size_t rowbase, int b, int gh, int dil, int L, int mm, int jbase, float Mc, int jl, int hi, f32x16 (&o)[NT][2], float (&lsum)[NT]) {
    bf16x8 qf[NT][4];
#pragma unroll
    for (int t = 0; t < NT; ++t) { const bf16* qrow = QB + ((size_t)(b * 24 + gh) * S_ + mm * L + jbase + 32 * t + jl) * 64;
#pragma unroll
        for (int ks = 0; ks < 4; ++ks) qf[t][ks] = *(const bf16x8*)(qrow + 16 * ks + 8 * hi);
#pragma unroll
        for (int r = 0; r < 16; ++r) { o[t][0][r] = 0.f; o[t][1][r] = 0.f; }
        lsum[t] = 0.f; }
    const int jb = jbase >> 5;
    const int kb_lo = max(jb - 2, 0), kb_hi = min(jb + NT + 1, (L >> 5) - 1);
    const bf16* vrow0 = VT + ((size_t)(b * 24 + gh) * 64 + ((mm * L) >> 5)) * 2048 + jl * 32;
#pragma unroll 1
    for (int kb = kb_lo; kb <= kb_hi; ++kb) {
        bf16x8 kf[4], vf[2][2];
        { const int kj_ = 32 * kb + swap23(jl); const bf16* krow_ = KB + ((size_t)(b * 24 + gh) * S_ + mm * L + kj_) * 64;
#pragma unroll
          for (int ks = 0; ks < 4; ++ks) kf[ks] = *(const bf16x8*)(krow_ + 16 * ks + 8 * hi); }
#pragma unroll
        for (int mb = 0; mb < 2; ++mb)
#pragma unroll
            for (int ks = 0; ks < 2; ++ks) vf[mb][ks] = *(const bf16x8*)(vrow0 + (size_t)kb * 2048 + 1024 * mb + 16 * ks + 8 * hi);
#pragma unroll
        for (int t = 0; t < NT; ++t) {
            if (kb >= jb + t - 2 && kb <= jb + t + 2) {
                const int qj = jbase + 32 * t + jl;
                f32x16 s;
#pragma unroll
                for (int r = 0; r < 16; ++r) s[r] = 0.f;
#pragma unroll
                for (int ks = 0; ks < 4; ++ks) s = __builtin_amdgcn_mfma_f32_32x32x16_bf16(kf[ks], qf[t][ks], s, 0, 0, 0);
                float p[16];
#pragma unroll
                for (int r = 0; r < 16; ++r) { const int key = 32 * kb + swap23(crow(r, hi)); const int dj = key - qj;
                    const float pv = __builtin_amdgcn_exp2f(s[r] - Mc); p[r] = (dj <= 64 && dj >= -64) ? pv : 0.f; lsum[t] += p[r]; }
#pragma unroll
                for (int ks = 0; ks < 2; ++ks) {
                    v4u pw; pw.x = pk2(p[8 * ks + 0], p[8 * ks + 1]); pw.y = pk2(p[8 * ks + 2], p[8 * ks + 3]); pw.z = pk2(p[8 * ks + 4], p[8 * ks + 5]); pw.w = pk2(p[8 * ks + 6], p[8 * ks + 7]);
                    const bf16x8 pf = __builtin_bit_cast(bf16x8, pw);
                    o[t][0] = __builtin_amdgcn_mfma_f32_32x32x16_bf16(vf[0][ks], pf, o[t][0], 0, 0, 0);
                    o[t][1] = __builtin_amdgcn_mfma_f32_32x32x16_bf16(vf[1][ks], pf, o[t][1], 0, 0, 0);
                }
            }
        }
    }
}
DI void attn_merge(LAS float* Ot, LAS float* Ls, bool first, int x, int hi, const f32x16& o0, const f32x16& o1, float lsum) {
    lsum += __shfl_xor(lsum, 32);
    const int cx = colx(x);
    if (first) {
#pragma unroll
        for (int r = 0; r < 16; ++r) { Ot[crow(r, hi) * 512 + cx] = o0[r]; Ot[(32 + crow(r, hi)) * 512 + cx] = o1[r]; }
        if (hi == 0) Ls[x] = lsum;
    } else {
#pragma unroll
        for (int r = 0; r < 16; ++r) { Ot[crow(r, hi) * 512 + cx] += o0[r]; Ot[(32 + crow(r, hi)) * 512 + cx] += o1[r]; }
        if (hi == 0) Ls[x] += lsum;
    }
}
DI void attn_unit(KP A, const bf16* QB, const bf16* KB, const bf16* VT, bf16* OA, int b, int h, int pb, LAS unsigned char* lds, int tid, int wave, int lane) {
    LAS float* Ot = (LAS float*)lds;
    LAS float* Ls = (LAS float*)(lds + 131072);
    const size_t rowbase = (size_t)b * S_;
    const int P = 512 * pb;
#pragma unroll 1
    for (int g = 0; g < 3; ++g) {
        const int ln_ = launder_v(lane); const int jl = ln_ & 31, hi = ln_ >> 5;
        const int dsh = 2 * g, dil = 1 << dsh, L = S_ >> dsh;
        const int gh = g * 8 + h;
        float mq = fabsf(kin(A, I_QNG)[g * 64 + ln_]), mk = fabsf(kin(A, I_KNG)[g * 64 + ln_]);
        mq = wave_max(mq); mk = wave_max(mk);
        const float Mc = 8.0f * mq * mk * 1.4426950408889634f;
        if (g < 2) {
            int mm, jbase, xa, xb;
            if (g == 0) { mm = 0; jbase = P + 64 * wave; xa = 64 * wave + jl; xb = xa + 32; }
            else { mm = wave & 3; const int jp = wave >> 2; jbase = (P >> 2) + 64 * jp; xa = 4 * (64 * jp + jl) + mm; xb = xa + 128; }
            f32x16 o[2][2]; float ls[2];
            attn_run<2>(QB, KB, VT, rowbase, b, gh, dil, L, mm, jbase, Mc, jl, hi, o, ls);
            attn_merge(Ot, Ls, g == 0, xa, hi, o[0][0], o[0][1], ls[0]);
            attn_merge(Ot, Ls, g == 0, xb, hi, o[1][0], o[1][1], ls[1]);
        } else {
#pragma unroll 1
            for (int sl = 0; sl < 2; ++sl) {
                const int mm = 2 * wave + sl, jbase = P >> 4, x = 16 * jl + mm;
                f32x16 o[1][2]; float ls[1];
                attn_run<1>(QB, KB, VT, rowbase, b, gh, dil, L, mm, jbase, Mc, jl, hi, o, ls);
                attn_merge(Ot, Ls, false, x, hi, o[0][0], o[0][1], ls[0]);
            }
        }
        __syncthreads();
    }
    {
        const int x = launder_v(tid), cx = colx(x);
        const float inv = 1.0f / Ls[x];
        bf16* orow = OA + (rowbase + P + x) * 512 + h * 64;
#pragma unroll
        for (int c = 0; c < 8; ++c) { float v[8];
#pragma unroll
            for (int e = 0; e < 8; ++e) v[e] = Ot[(8 * c + e) * 512 + cx] * inv;
            v4u w; w.x = pk2(v[0], v[1]); w.y = pk2(v[2], v[3]); w.z = pk2(v[4], v[5]); w.w = pk2(v[6], v[7]);
            *(v4u*)(orow + 8 * c) = w; }
    }
    __syncthreads();
}

DI void p4b_ffn_act(KP A, const bf16* UP, bf16* H, int Tc, int tid, int G) {
    const int gt = blockIdx.x * (NWAVES * 64) + tid, NGT = G * NWAVES * 64;
    const int nitems = (Tc / 8) * 384;
    for (int it = gt; it < nitems; it += NGT) {
        const int cc = it % 384, tg = it / 384; const int ch = 8 * cc; const int t0 = 8 * tg; const int pos0 = t0 & (S_ - 1);
        float w0[8], w1[8], w2[8], bb[8];
        { const float* p = kin(A, I_FCW) + ch; const f32x4 a0 = *(const f32x4*)p, a1 = *(const f32x4*)(p + 4), b0 = *(const f32x4*)(p + DFF), b1 = *(const f32x4*)(p + DFF + 4), c0 = *(const f32x4*)(p + 2 * DFF), c1 = *(const f32x4*)(p + 2 * DFF + 4);
          const f32x4 d0 = *(const f32x4*)(kin(A, I_FCB) + ch), d1 = *(const f32x4*)(kin(A, I_FCB) + ch + 4);
#pragma unroll
          for (int e = 0; e < 4; ++e) { w0[e] = a0[e]; w0[e + 4] = a1[e]; w1[e] = b0[e]; w1[e + 4] = b1[e]; w2[e] = c0[e]; w2[e + 4] = c1[e]; bb[e] = d0[e]; bb[e + 4] = d1[e]; } }
        const bf16* gp = UP + (size_t)t0 * 6144 + ch;
        float gm[8], gc[8], gn[8];
        { v4u w = (v4u){0u, 0u, 0u, 0u}; if (pos0 != 0) w = *(const v4u*)(gp - 6144);
          gm[0] = bflo(w.x); gm[1] = bfhi(w.x); gm[2] = bflo(w.y); gm[3] = bfhi(w.y); gm[4] = bflo(w.z); gm[5] = bfhi(w.z); gm[6] = bflo(w.w); gm[7] = bfhi(w.w); }
        { const v4u w = *(const v4u*)gp;
          gc[0] = bflo(w.x); gc[1] = bfhi(w.x); gc[2] = bflo(w.y); gc[3] = bfhi(w.y); gc[4] = bflo(w.z); gc[5] = bfhi(w.z); gc[6] = bflo(w.w); gc[7] = bfhi(w.w); }
#pragma unroll
        for (int i = 0; i < 8; ++i) {
            v4u w = (v4u){0u, 0u, 0u, 0u}; if (i < 7 || pos0 + 8 < S_) w = *(const v4u*)(gp + (size_t)(i + 1) * 6144);
            gn[0] = bflo(w.x); gn[1] = bfhi(w.x); gn[2] = bflo(w.y); gn[3] = bfhi(w.y); gn[4] = bflo(w.z); gn[5] = bfhi(w.z); gn[6] = bflo(w.w); gn[7] = bfhi(w.w);
            const v4u vw = *(const v4u*)(gp + (size_t)i * 6144 + DFF);
            const float vv[8] = {bflo(vw.x), bfhi(vw.x), bflo(vw.y), bfhi(vw.y), bflo(vw.z), bfhi(vw.z), bflo(vw.w), bfhi(vw.w)};
            float o[8];
#pragma unroll
            for (int e = 0; e < 8; ++e) { const float pre = bb[e] + w0[e] * gm[e] + w1[e] * gc[e] + w2[e] * gn[e]; o[e] = gelu_t(pre) * vv[e]; gm[e] = gc[e]; gc[e] = gn[e]; }
            v4u ow; ow.x = pk2(o[0], o[1]); ow.y = pk2(o[2], o[3]); ow.z = pk2(o[4], o[5]); ow.w = pk2(o[6], o[7]);
            *(v4u*)(H + (size_t)(t0 + i) * DFF + ch) = ow;
        }
    }
}

DI void p4c_fixup(KP A, const float* SB, bf16* H, int Tc, int tid, int G) {
    const int gt = blockIdx.x * (NWAVES * 64) + tid, NGT = G * NWAVES * 64;
    const int nedge = (Tc / 256) * 8, nitems = nedge * 768;
    for (int it = gt; it < nitems; it += NGT) {
        const int c4 = it % 768, e = it / 768; const int ch = 4 * c4;
        const int last = e & 1, run = (e >> 1) & 3, tile = e >> 3; const int row = tile * 256 + run * 64 + (last ? 63 : 0); const int pos = row & (S_ - 1);
        const float* sb = SB + (size_t)e * 9216 + ch;
        f32x4 pre = *(const f32x4*)(sb + 3072); const f32x4 v = *(const f32x4*)(sb + 6144);
        if (!last && pos != 0) { const f32x4 gnb = *(const f32x4*)(sb - 9216); const f32x4 w0 = *(const f32x4*)(kin(A, I_FCW) + ch); pre = pre + w0 * gnb; }
        if (last && pos != S_ - 1) { const f32x4 gnb = *(const f32x4*)(sb + 9216); const f32x4 w2 = *(const f32x4*)(kin(A, I_FCW) + 2 * DFF + ch); pre = pre + w2 * gnb; }
        v2u w; w.x = pk2(gelu_t(pre[0]) * v[0], gelu_t(pre[1]) * v[1]); w.y = pk2(gelu_t(pre[2]) * v[2], gelu_t(pre[3]) * v[3]);
        *(v2u*)(H + (size_t)row * DFF + ch) = w;
    }
}

#define XB_TMO      128
#define XB_XCNT(j)  (256  + 64 * (j))
#define XB_XSUB(j)  (1280 + 64 * (j))
#define XB_XGEN(j)  (2304 + 64 * (j))
#define XB_TOP      3328
#define XB_TOPGEN   3392
#define XCD_BAR_WORDS 3456
#define XB_SPIN_CAP (1u << 18)

__device__ __forceinline__ unsigned xb_ld(unsigned* p)              { return __hip_atomic_load(p, __ATOMIC_RELAXED, __HIP_MEMORY_SCOPE_AGENT); }
__device__ __forceinline__ unsigned xb_add(unsigned* p, unsigned v) { return __hip_atomic_fetch_add(p, v, __ATOMIC_RELAXED, __HIP_MEMORY_SCOPE_AGENT); }
__device__ __forceinline__ unsigned xb_xcc_id() { return (unsigned)__builtin_amdgcn_s_getreg((3 << 11) | 20) & 0xFu; }
#define XB_SPIN(cond, bar) do { unsigned _sp = 0; while (cond) { __builtin_amdgcn_s_sleep(1); \
    if ((++_sp & 255u) == 0u) { if (xb_ld(&(bar)[XB_TMO])) break; if (_sp > XB_SPIN_CAP) { atomicAdd(&(bar)[XB_TMO], 1u); break; } } } } while (0)

struct XcdBarrier {
    unsigned* bar; unsigned x;
    volatile LAS unsigned* st;
};

__device__ __forceinline__ XcdBarrier xcd_barrier_post(unsigned* bar, volatile LAS unsigned* st) {
    XcdBarrier b; b.bar = bar; b.x = xb_xcc_id(); b.st = st;
    if (threadIdx.x == 0) (void)xb_add(&bar[XB_XCNT(b.x)], 1u);
    return b;
}
__device__ __forceinline__ void xcd_barrier_complete(unsigned* bar, unsigned x, unsigned& nloc, unsigned& nx) {
    const unsigned G = gridDim.x * gridDim.y * gridDim.z;
    unsigned sum, cnt, mine, sp = 0u;
    for (;;) {
        sum = 0u; cnt = 0u; mine = 0u;
#pragma unroll
        for (unsigned j = 0; j < 16; ++j) { const unsigned c = xb_ld(&bar[XB_XCNT(j)]); sum += c; cnt += (c > 0u) ? 1u : 0u; mine = (j == x) ? c : mine; }
        if (sum == G) break;
        __builtin_amdgcn_s_sleep(1);
        if ((++sp & 255u) == 0u) { if (xb_ld(&bar[XB_TMO])) break; if (sp > XB_SPIN_CAP) { atomicAdd(&bar[XB_TMO], 1u); break; } }
    }
    nloc = mine > 0u ? mine : 1u; nx = cnt > 0u ? cnt : 1u;
}

__device__ __forceinline__ void xcd_barrier(const XcdBarrier& b) {
    asm volatile("s_waitcnt vmcnt(0)" ::: "memory");
    __syncthreads();
    if (threadIdx.x == 0) {
        unsigned* bar = b.bar;
        __builtin_amdgcn_s_waitcnt(0);
        unsigned nloc = b.st[0], nx = b.st[1];
        if (nloc == 0u) { xcd_barrier_complete(bar, b.x, nloc, nx); b.st[0] = nloc; b.st[1] = nx; }
        const unsigned old = xb_add(&bar[XB_XSUB(b.x)], 1u);
        const unsigned gen = old / nloc;
        if (old + 1u == (gen + 1u) * nloc) {
            __builtin_amdgcn_fence(__ATOMIC_RELEASE, "agent");
            asm volatile("s_waitcnt vmcnt(0)" ::: "memory");
            const unsigned og = xb_add(&bar[XB_TOP], 1u);
            const unsigned tg = og / nx;
            if (og + 1u == (tg + 1u) * nx) xb_add(&bar[XB_TOPGEN], 1u);
            else XB_SPIN(xb_ld(&bar[XB_TOPGEN]) == tg, bar);
            __builtin_amdgcn_fence(__ATOMIC_ACQUIRE, "agent");
            xb_add(&bar[XB_XGEN(b.x)], 1u);
            asm volatile("s_waitcnt vmcnt(0)" ::: "memory");
        } else {
            XB_SPIN(xb_ld(&bar[XB_XGEN(b.x)]) == gen, bar);
            __builtin_amdgcn_fence(__ATOMIC_ACQUIRE, "agent");
            asm volatile("s_waitcnt vmcnt(0)" ::: "memory");
        }
    }
    __syncthreads();
}

constexpr size_t CTL_BAR = 512 * 1024;
DI void grid_bar_cg() { cg::this_grid().sync(); }
DI void grid_bar(LAS unsigned char* lds) {
    const KP k = kp_fresh();
    XcdBarrier b; b.bar = (unsigned*)(kws(k) + WS_CTL + CTL_BAR); b.x = xb_xcc_id(); b.st = (volatile LAS unsigned*)(lds + MISC_OFF + 32);
    xcd_barrier(b);
}
struct Ctx { int Tc, grow0, G; unsigned char* ws; bf16 *XN, *MG, *PROJ, *H, *HG, *OA, *XL, *GL, *QB, *KB, *VB, *GT; float* out; float* SS; };
DI Ctx make_ctx(KP k, int c) {
    Ctx X; const int Tm = kspc(k) * S_; X.Tc = kcnt(k, c) * S_; X.grow0 = kstart(k, c) * S_; X.G = gridDim.x; X.ws = kws(k); X.out = kout(k);
    X.SS = (float*)(X.ws + WS_CTL + CTL_SS);
    X.XN = (bf16*)(X.ws + WS_ACT); X.MG = (bf16*)(X.ws + WS_ACT + (size_t)Tm * 2048); X.PROJ = (bf16*)(X.ws + WS_ACT + (size_t)Tm * 4096);
    X.H = (bf16*)(X.ws + WS_ACT + (size_t)Tm * 4096 + (size_t)Tm * 8192);
    { unsigned char* rg = (unsigned char*)X.PROJ; X.XL = (bf16*)rg; X.GL = (bf16*)(rg + (size_t)Tm * 2560); X.QB = (bf16*)(rg + (size_t)Tm * 5120); X.KB = (bf16*)(rg + (size_t)Tm * 8192); X.VB = (bf16*)(rg + (size_t)Tm * 11264); X.GT = (bf16*)(rg + (size_t)Tm * 14336); }
    X.HG = (bf16*)(X.out + (size_t)X.grow0 * 1024); X.OA = (bf16*)((unsigned char*)X.HG + (size_t)X.Tc * 2560);
    return X;
}
#define PH_PRE(c) const int tid = launder_v(threadIdx.x), lane = tid & 63, wave = __builtin_amdgcn_readfirstlane(tid >> 6); (void)lane; (void)wave; const KP k = kp_fresh(); const Ctx X = make_ctx(k, launder_i(c));
DI void ph_p0(LAS unsigned char* lds) { PH_PRE(0) p0_weights(k, lds, tid, wave, lane, X.G); p0_xn(k, X.XN, X.grow0, X.Tc, wave, lane, X.G); }
DI void ph_p1(LAS unsigned char* lds, int c) { PH_PRE(c)
    pg8::Gemm g{(c == 0) ? X.XN : X.MG, (const bf16*)(X.ws + WS_WIN), X.Tc, INC, 1024}; pg8::StaticOrder S; S.init(X.Tc, INC, X.G, launder_i((int)blockIdx.x));
    pg8::EpiProj E{X.XL, X.GL, X.QB, X.KB, X.VB, X.GT, (const float*)(X.ws + WS_ROPE), kin(k, I_QNG), kin(k, I_KNG), QSCALE};
    pg8::gemm_phase<pg8::EpiProj, pg8::StaticOrder, true, true>(lds, g, S, E); }
DI void ph_p1b(LAS unsigned char* lds, int c) { PH_PRE(c) p1b_qknorm_vt(k, X.VB, X.XN, X.Tc, lds, wave, lane, X.G); }
constexpr size_t CTL_Q = 768 * 1024;
DI void ph_p2(LAS unsigned char* lds, int c, int cslot, int what) { PH_PRE(c)
    volatile LAS int* misc = (volatile LAS int*)(lds + MISC_OFF);
    unsigned* qh = (unsigned*)(X.ws + WS_CTL + CTL_Q) + 64 * 8 * cslot;
    const int spc = X.Tc / S_;
    const int n_lru8 = spc * 2, n_att8 = spc * 4, total8 = n_lru8 + n_att8;
    const int myx = (int)(xb_xcc_id() & 7u);
#pragma unroll 1
    for (int hop = 0; hop < 8; ++hop) {
        const int xq = (myx + hop) & 7;
        for (;;) {
            if (tid == 0) misc[0] = (int)atomicAdd(qh + 64 * xq, 1u);
            __syncthreads();
            const int q = misc[0];
            __syncthreads();
            if (q >= total8) break;
            if (q < n_lru8) { const int item = xq + 8 * q; if (what & 1) lru_item(k, X.XL, X.GL, X.HG, item / 16, item % 16, lds, tid, wave, lane); }
            else if (what & 2) { const int qa = q - n_lru8; const int bh = xq + 8 * (qa >> 2), pb = qa & 3; attn_unit(k, X.QB, X.KB, X.XN, X.OA, bh >> 3, bh & 7, pb, lds, tid, wave, lane); }
        }
    } }
DI void ph_p3a1(LAS unsigned char* lds, int c) { PH_PRE(c)
    pg8::Gemm g{X.HG, (const bf16*)(X.ws + WS_WLO), X.Tc, 1024, 1280}; pg8::StaticOrder S; S.init(X.Tc, 1024, X.G, launder_i((int)blockIdx.x));
    pg8::EpiMerge<false> E{X.MG, (const unsigned char*)X.GT, 2048};
    pg8::gemm_phase<pg8::EpiMerge<false>, pg8::StaticOrder, true, true>(lds, g, S, E); }
DI void ph_p3a2(LAS unsigned char* lds, int c) { PH_PRE(c)
    pg8::Gemm g{X.OA, (const bf16*)(X.ws + WS_WAO), X.Tc, 1024, 512}; pg8::StaticOrder S; S.init(X.Tc, 1024, X.G, launder_i((int)blockIdx.x));
    pg8::EpiMerge<true> E{X.MG, (const unsigned char*)X.GT + 1024, 2048};
    pg8::gemm_phase<pg8::EpiMerge<true>, pg8::StaticOrder, true, true>(lds, g, S, E); }
DI void ph_p3b(LAS unsigned char* lds, int c) { PH_PRE(c)
    pg8::Gemm g{X.MG, (const bf16*)(X.ws + WS_WO), X.Tc, 1024, 1024}; pg8::StaticOrder S; S.init(X.Tc, 1024, X.G, launder_i((int)blockIdx.x));
    pg8::EpiWo E{kin(k, I_XP), kin(k, I_XS), X.out, X.XN, X.SS, X.grow0};
    pg8::gemm_phase<pg8::EpiWo, pg8::StaticOrder, true, true>(lds, g, S, E); }
DI void ph_p4(LAS unsigned char* lds, int c) { PH_PRE(c)
    pg8::Gemm g{X.XN, (const bf16*)(X.ws + WS_WUP), X.Tc, 6144, 1024}; pg8::StaticOrder S; S.init(X.Tc, 6144, X.G, launder_i((int)blockIdx.x));
    pg8::EpiUpFused E{X.H, X.SS, X.grow0, kin(k, I_FCW), kin(k, I_FCB), (float*)X.PROJ};
    pg8::gemm_phase<pg8::EpiUpFused, pg8::StaticOrder, true, true>(lds, g, S, E); }
DI void ph_p4b(LAS unsigned char* lds, int c) { PH_PRE(c) p4c_fixup(k, (const float*)X.PROJ, X.H, X.Tc, tid, X.G); }
DI void ph_p5(LAS unsigned char* lds, int c) { PH_PRE(c)
    pg8::Gemm g{X.H, (const bf16*)(X.ws + WS_WDN), X.Tc, 1024, 3072}; pg8::StaticOrder S; S.init(X.Tc, 1024, X.G, launder_i((int)blockIdx.x));
    pg8::EpiDown E{X.out, X.XN, X.grow0};
    pg8::gemm_phase<pg8::EpiDown, pg8::StaticOrder, true, true>(lds, g, S, E); }
DI void ph_xn_next(LAS unsigned char* lds, int c) { PH_PRE(c) p0_xn(k, X.MG, kstart(k, c + 1) * S_, kcnt(k, c + 1) * S_, wave, lane, X.G); }

__global__ void __launch_bounds__(NWAVES * 64, 2) hybrid_fwd(Args args) {
    extern __shared__ __attribute__((aligned(16))) unsigned char lds_raw[];
    LAS unsigned char* lds = (LAS unsigned char*)lds_raw;
    const int nchunks = args.nch;
    { volatile LAS unsigned* st = (volatile LAS unsigned*)(lds + MISC_OFF); if (threadIdx.x < 64) st[threadIdx.x] = 0u; __syncthreads();
      (void)xcd_barrier_post((unsigned*)(args.ws + WS_CTL + CTL_BAR), (volatile LAS unsigned*)(lds + MISC_OFF + 32)); }
    if (PHM & 1) ph_p0(lds);
    if (REP & 1) { grid_bar_cg(); ph_p0(lds); }
    cg::this_grid().sync();
#pragma unroll 1
    for (int c = 0; c < nchunks; ++c) {
        if (PHM & 2) ph_p1(lds, c);
        grid_bar(lds);
        if (REP & 2) { ph_p1(lds, c); grid_bar(lds); }
        if (PHM & 4) ph_p1b(lds, c);
        grid_bar(lds);
        if (REP & 4) { ph_p1b(lds, c); grid_bar(lds); }
        ph_p2(lds, c, c, 3);
        grid_bar(lds);
        if (REP & 8) { ph_p2(lds, c, c + 8, 3); grid_bar(lds); }
        if (REP & 16) { ph_p2(lds, c, c + 16, 1); grid_bar(lds); }
        if (REP & 32768) { ph_p2(lds, c, c + 24, 2); grid_bar(lds); }
        if (PHM & 32) ph_p3a1(lds, c);
        if (PHM & 64) ph_p3a2(lds, c);
        grid_bar(lds);
        if (REP & 32) { ph_p3a1(lds, c); ph_p3a2(lds, c); grid_bar(lds); }
        if (PHM & 128) ph_p3b(lds, c);
        grid_bar(lds);
        if (PHM & 256) ph_p4(lds, c);
        grid_bar(lds);
        if (REP & 256) { ph_p4(lds, c); grid_bar(lds); }
        if (PHM & 512) ph_p4b(lds, c);
        grid_bar(lds);
        if (REP & 512) { ph_p4b(lds, c); grid_bar(lds); }
        if (PHM & 1024) ph_p5(lds, c);
        if (c + 1 < nchunks) { if (PHM & 1) ph_xn_next(lds, c); grid_bar(lds); }
    }
}

extern "C" void kernel_launch(void* const* d_in, const int* in_sizes, int n_in, void* d_out, int out_size, void* d_ws, size_t ws_size, hipStream_t stream) {
    static int grid = 0, spc = 0;
    if (grid == 0) {
        int dev = 0, cus = 0, per_cu = 0;
        if (hipGetDevice(&dev) != hipSuccess || hipDeviceGetAttribute(&cus, hipDeviceAttributeMultiprocessorCount, dev) != hipSuccess) { fprintf(stderr, "kernel_launch: device query failed\n"); grid = -1; return; }
        if (hipFuncSetAttribute((const void*)hybrid_fwd, hipFuncAttributeMaxDynamicSharedMemorySize, LDS_BYTES) != hipSuccess) { fprintf(stderr, "kernel_launch: hipFuncSetAttribute failed\n"); grid = -1; return; }
        if (hipOccupancyMaxActiveBlocksPerMultiprocessor(&per_cu, (const void*)hybrid_fwd, NWAVES * 64, LDS_BYTES) != hipSuccess || per_cu < 1) { fprintf(stderr, "kernel_launch: occupancy query gives %d\n", per_cu); per_cu = 1; }
        (void)hipGetLastError();
        grid = cus;
        const int cand[8] = {24, 16, 8, 5, 4, 2, 1, 0};
        for (int i = 0; cand[i]; ++i) if (WS_ACT + (size_t)cand[i] * S_ * ACT_PER_TOK <= ws_size) { spc = cand[i]; break; }
        if (spc == 0) { fprintf(stderr, "kernel_launch: workspace too small (%zu)\n", ws_size); grid = -1; return; }
        fprintf(stderr, "kernel_launch: grid %d, per_cu %d, spc %d, ws %zu\n", grid, per_cu, spc, ws_size);
    }
    if (grid < 0) return;
    (void)hipMemsetAsync((char*)d_ws + WS_CTL, 0, CTL_BYTES, stream);
    Args a{};
    for (int i = 0; i < 21; ++i) a.in[i] = (const float*)d_in[i];
    a.out = (float*)d_out; a.ws = (unsigned char*)d_ws; a.spc = spc;
    { int st = 0, n = 0; while (st < NSEQ && n < 6) { const int m = (NSEQ - st < spc) ? NSEQ - st : spc; a.start[n] = st; a.cnt[n] = m; st += m; ++n; } a.nch = n;
      if (st < NSEQ) { fprintf(stderr, "kernel_launch: too many chunks\n"); return; } }
    void* kargs[] = {&a};
    hipError_t e = hipLaunchCooperativeKernel((const void*)hybrid_fwd, dim3(grid), dim3(NWAVES * 64), kargs, LDS_BYTES, stream);
    if (e != hipSuccess) fprintf(stderr, "kernel_launch: cooperative launch failed: %s (grid %d)\n", hipGetErrorString(e), grid);
}
```
